# Optimizing an MI355X kernel written in HIP

```python
import jax, jax.numpy as jnp
from jax import lax
import numpy as np

D_MODEL = 2048
BATCH = 16
SEQ = 2048
DEPTH = 4

N_MIXERS = 2
N_HGRN_LAYERS = (DEPTH + 1) // 2
N_GDN_LAYERS = DEPTH // 2

HG_DK = 128
HG_HEADS = D_MODEL // HG_DK
HG_DV = D_MODEL // HG_HEADS
HG_CHUNK = 16
HG_IN = 2 * HG_HEADS * HG_DK + 2 * HG_HEADS * HG_DV

GDN_DK = 128
GDN_DV = 128
GDN_K_HEADS = D_MODEL // 128
GDN_V_HEADS = 2 * GDN_K_HEADS
GDN_KEY_DIM = GDN_K_HEADS * GDN_DK
GDN_VAL_DIM = GDN_V_HEADS * GDN_DV
GDN_CONV = 4
GDN_CONV_DIM = 2 * GDN_KEY_DIM + GDN_VAL_DIM
GDN_IN = GDN_CONV_DIM + GDN_VAL_DIM + 2 * GDN_V_HEADS
GDN_CHUNK = 64

FFN_HIDDEN = -(-(8 * D_MODEL) // (3 * 256)) * 256
N_MOD = 6
EPS = 1e-6

kernel_name = "hybrid_hgrn2_gdn_adaln_trunk"


def rms_norm(x, w, eps=EPS):
    xf = x.astype(jnp.float32)
    y = xf * lax.rsqrt(jnp.mean(xf * xf, axis=-1, keepdims=True) + eps)
    return (y * w.astype(jnp.float32)).astype(x.dtype)


def l2_normalize(x, eps=EPS):
    xf = x.astype(jnp.float32)
    return xf * lax.rsqrt(jnp.sum(xf * xf, axis=-1, keepdims=True) + eps)


def causal_depthwise_conv(x, w):
    K = w.shape[0]
    S = x.shape[1]
    xp = jnp.pad(x, ((0, 0), (K - 1, 0), (0, 0)))
    out = xp[:, 0:S, :] * w[0]
    for j in range(1, K):
        out = out + xp[:, j:j + S, :] * w[j]
    return out


def hgrn2_chunked(q, k, v, log_f):
    B, S, H, DK = q.shape
    DV = v.shape[-1]
    C = HG_CHUNK
    N = S // C

    def to_chunks(t):
        return t.reshape(B, N, C, H, t.shape[-1]).transpose(1, 0, 3, 2, 4)

    qc, kc, vc, gc = to_chunks(q), to_chunks(k), to_chunks(v), to_chunks(log_f)
    causal = jnp.tril(jnp.ones((C, C), dtype=bool))

    def step(state, inp):
        q_n, k_n, v_n, g_n = inp
        b = jnp.cumsum(g_n, axis=-2)
        b_last = b[..., -1:, :]
        o_inter = jnp.einsum('bhtk,bhkv->bhtv', q_n * jnp.exp(b), state)
        diff = jnp.where(causal[:, :, None], b[..., :, None, :] - b[..., None, :, :], -jnp.inf)
        scores = jnp.einsum('bhtk,bhsk,bhtsk->bhts', q_n, k_n, jnp.exp(diff))
        o = o_inter + jnp.einsum('bhts,bhsv->bhtv', scores, v_n)
        state = state * jnp.exp(b_last[..., 0, :])[..., None] + jnp.einsum(
            'bhsk,bhsv->bhkv', k_n * jnp.exp(b_last - b), v_n)
        return state, o

    state0 = jnp.zeros((B, H, DK, DV), jnp.float32)
    _, oc = lax.scan(step, state0, (qc, kc, vc, gc))
    return oc.transpose(1, 0, 3, 2, 4).reshape(B, S, H, DV)


def hgrn2_mixer(h, w_in, lower_bound, norm_w, w_out):
    B, S, _ = h.shape
    proj = h @ w_in
    hk = HG_HEADS * HG_DK
    hv = HG_HEADS * HG_DV
    q = jax.nn.silu(proj[..., :hk].astype(jnp.float32))
    f_logit = proj[..., hk:2 * hk].astype(jnp.float32)
    i_val = proj[..., 2 * hk:2 * hk + hv].astype(jnp.float32)
    out_gate = proj[..., 2 * hk + hv:].astype(jnp.float32)
    lb = lower_bound.astype(jnp.float32)
    log_f = jnp.logaddexp(jnp.log(lb), jnp.log1p(-lb) + jax.nn.log_sigmoid(f_logit))
    k = -jnp.expm1(log_f)
    o = hgrn2_chunked(q.reshape(B, S, HG_HEADS, HG_DK), k.reshape(B, S, HG_HEADS, HG_DK),
                      i_val.reshape(B, S, HG_HEADS, HG_DV), log_f.reshape(B, S, HG_HEADS, HG_DK))
    o = rms_norm(o, norm_w) * jax.nn.sigmoid(out_gate.reshape(B, S, HG_HEADS, HG_DV))
    return o.reshape(B, S, hv).astype(h.dtype) @ w_out


def gated_delta_chunked(q, k, v, beta, g):
    B, S, H, DK = q.shape
    DV = v.shape[-1]
    C = GDN_CHUNK
    N = S // C

    def chunk_vec(t):
        return t.reshape(B, N, C, H, t.shape[-1]).transpose(0, 3, 1, 2, 4)

    def chunk_sca(t):
        return t.reshape(B, N, C, H).transpose(0, 3, 1, 2)

    qc, kc, vc = chunk_vec(q), chunk_vec(k), chunk_vec(v)
    bc, gcum = chunk_sca(beta), jnp.cumsum(chunk_sca(g), axis=-1)
    causal = jnp.tril(jnp.ones((C, C), dtype=bool))
    strict = jnp.tril(jnp.ones((C, C), dtype=bool), -1)
    decay = jnp.exp(jnp.where(causal, gcum[..., :, None] - gcum[..., None, :], -jnp.inf))
    kk = jnp.einsum('bhntk,bhnsk->bhnts', kc, kc)
    a_low = jnp.where(strict, bc[..., :, None] * kk * decay, 0.0)
    eye = jnp.broadcast_to(jnp.eye(C, dtype=jnp.float32), a_low.shape)
    t_inv = lax.linalg.triangular_solve(a_low, eye, left_side=True, lower=True, unit_diagonal=True)
    u = jnp.einsum('bhnts,bhnsv->bhntv', t_inv, vc * bc[..., None])
    w = jnp.einsum('bhnts,bhnsk->bhntk', t_inv, kc * (bc * jnp.exp(gcum))[..., None])
    attn = jnp.where(causal, jnp.einsum('bhntk,bhnsk->bhnts', qc, kc) * decay, 0.0)

    def step(state, inp):
        q_n, k_n, u_n, w_n, attn_n, g_n = inp
        v_new = u_n - jnp.einsum('bhck,bhkv->bhcv', w_n, state)
        o = jnp.einsum('bhck,bhkv->bhcv', q_n * jnp.exp(g_n)[..., None], state) + jnp.einsum(
            'bhts,bhsv->bhtv', attn_n, v_new)
        g_last = g_n[..., -1:]
        state = state * jnp.exp(g_last)[..., None] + jnp.einsum(
            'bhck,bhcv->bhkv', k_n * jnp.exp(g_last - g_n)[..., None], v_new)
        return state, o

    mv = lambda t: jnp.moveaxis(t, 2, 0)
    state0 = jnp.zeros((B, H, DK, DV), jnp.float32)
    _, oc = lax.scan(step, state0, (mv(qc), mv(kc), mv(u), mv(w), mv(attn), mv(gcum)))
    return jnp.moveaxis(oc, 0, 2).transpose(0, 2, 3, 1, 4).reshape(B, S, H, DV)


def gdn_mixer(h, w_in, conv_w, a_log, dt_bias, norm_w, w_out):
    B, S, _ = h.shape
    proj = h @ w_in
    qkv = jax.nn.silu(causal_depthwise_conv(proj[..., :GDN_CONV_DIM], conv_w)).astype(jnp.float32)
    z = proj[..., GDN_CONV_DIM:GDN_CONV_DIM + GDN_VAL_DIM].astype(jnp.float32)
    b_logit = proj[..., GDN_CONV_DIM + GDN_VAL_DIM:GDN_CONV_DIM + GDN_VAL_DIM + GDN_V_HEADS].astype(jnp.float32)
    a_in = proj[..., GDN_CONV_DIM + GDN_VAL_DIM + GDN_V_HEADS:].astype(jnp.float32)
    rep = GDN_V_HEADS // GDN_K_HEADS
    q = l2_normalize(qkv[..., :GDN_KEY_DIM].reshape(B, S, GDN_K_HEADS, GDN_DK))
    k = l2_normalize(qkv[..., GDN_KEY_DIM:2 * GDN_KEY_DIM].reshape(B, S, GDN_K_HEADS, GDN_DK))
    v = qkv[..., 2 * GDN_KEY_DIM:].reshape(B, S, GDN_V_HEADS, GDN_DV)
    q = jnp.repeat(q, rep, axis=2) * (GDN_DK ** -0.5)
    k = jnp.repeat(k, rep, axis=2)
    beta = jax.nn.sigmoid(b_logit)
    g = -jnp.exp(a_log.astype(jnp.float32)) * jax.nn.softplus(a_in + dt_bias.astype(jnp.float32))
    o = gated_delta_chunked(q, k, v, beta, g)
    o = rms_norm(o, norm_w) * jax.nn.silu(z.reshape(B, S, GDN_V_HEADS, GDN_DV))
    return o.reshape(B, S, GDN_VAL_DIM).astype(h.dtype) @ w_out


def swiglu_ffn(h, w_gate_up, w_down):
    gu = h @ w_gate_up
    return (jax.nn.silu(gu[..., :FFN_HIDDEN]) * gu[..., FFN_HIDDEN:]) @ w_down


def setup_inputs(seed: int = 0) -> dict:
    key = jax.random.key(seed)
    ks = jax.random.split(key, 20)
    f32 = jnp.float32

    def nrm(k, shape, scale):
        return jax.random.normal(k, shape, f32) * scale

    dt = jnp.exp(jax.random.uniform(ks[13], (N_GDN_LAYERS, GDN_V_HEADS), f32,
                                    np.log(1e-3).astype(np.float32), np.log(1e-1).astype(np.float32)))
    return {
        "x": nrm(ks[0], (BATCH, SEQ, D_MODEL), 1.0),
        "c": nrm(ks[1], (BATCH, D_MODEL), 1.0),
        "ada_w": nrm(ks[2], (DEPTH, D_MODEL, N_MOD * D_MODEL), 0.5 * D_MODEL ** -0.5),
        "ada_b": nrm(ks[3], (DEPTH, N_MOD * D_MODEL), 0.01),
        "norm_w": 1.0 + nrm(ks[4], (DEPTH, 4, D_MODEL), 0.02),
        "hg_w_in": nrm(ks[5], (N_HGRN_LAYERS, D_MODEL, HG_IN), D_MODEL ** -0.5),
        "hg_lb_logits": nrm(ks[6], (N_HGRN_LAYERS, HG_HEADS * HG_DK), 0.5),
        "hg_norm_w": 1.0 + nrm(ks[7], (N_HGRN_LAYERS, HG_DV), 0.02),
        "hg_w_out": nrm(ks[8], (N_HGRN_LAYERS, HG_HEADS * HG_DV, D_MODEL), (HG_HEADS * HG_DV) ** -0.5),
        "gdn_w_in": nrm(ks[9], (N_GDN_LAYERS, D_MODEL, GDN_IN), D_MODEL ** -0.5),
        "gdn_conv_w": nrm(ks[10], (N_GDN_LAYERS, GDN_CONV, GDN_CONV_DIM), GDN_CONV ** -0.5),
        "gdn_A_log": jnp.log(jax.random.uniform(ks[11], (N_GDN_LAYERS, GDN_V_HEADS), f32, 1.0, 16.0)),
        "gdn_dt_bias": dt + jnp.log(-jnp.expm1(-dt)),
        "gdn_norm_w": 1.0 + nrm(ks[12], (N_GDN_LAYERS, GDN_DV), 0.02),
        "gdn_w_out": nrm(ks[14], (N_GDN_LAYERS, GDN_VAL_DIM, D_MODEL), GDN_VAL_DIM ** -0.5),
        "ffn_w_gate_up": nrm(ks[15], (DEPTH, D_MODEL, 2 * FFN_HIDDEN), D_MODEL ** -0.5),
        "ffn_w_down": nrm(ks[16], (DEPTH, FFN_HIDDEN, D_MODEL), FFN_HIDDEN ** -0.5),
    }


def reference(x, c, ada_w, ada_b, norm_w, hg_w_in, hg_lb_logits, hg_norm_w, hg_w_out,
              gdn_w_in, gdn_conv_w, gdn_A_log, gdn_dt_bias, gdn_norm_w, gdn_w_out,
              ffn_w_gate_up, ffn_w_down):
    lb_table = jnp.cumsum(jax.nn.softmax(hg_lb_logits.astype(jnp.float32), axis=0), axis=0)
    lb_table = lb_table - lb_table[:1]
    c_act = jax.nn.silu(c)
    for layer in range(DEPTH):
        mod = c_act @ ada_w[layer] + ada_b[layer]
        shift_m, scale_m, gate_m, shift_f, scale_f, gate_f = jnp.split(mod[:, None, :], N_MOD, axis=-1)
        h = rms_norm(x, norm_w[layer, 0]) * (1.0 + scale_m) + shift_m
        j = layer // N_MIXERS
        if layer % N_MIXERS == 0:
            y = hgrn2_mixer(h, hg_w_in[j], lb_table[j], hg_norm_w[j], hg_w_out[j])
        else:
            y = gdn_mixer(h, gdn_w_in[j], gdn_conv_w[j], gdn_A_log[j], gdn_dt_bias[j],
                          gdn_norm_w[j], gdn_w_out[j])
        x = x + gate_m * rms_norm(y, norm_w[layer, 1])
        h = rms_norm(x, norm_w[layer, 2]) * (1.0 + scale_f) + shift_f
        y = swiglu_ffn(h, ffn_w_gate_up[layer], ffn_w_down[layer])
        x = x + gate_f * rms_norm(y, norm_w[layer, 3])
    return x
```

```cpp
#include <hip/hip_runtime.h>
#include <cstdio>
#include <cstdint>
namespace pg8 {
#define PG8_LAS __attribute__((address_space(3)))
typedef unsigned short bf16_t;
typedef short bf16x8 __attribute__((ext_vector_type(8)));
typedef float f32x4 __attribute__((ext_vector_type(4)));
typedef unsigned u32x4 __attribute__((ext_vector_type(4)));
constexpr int BM = 256, BK = 64, HALF = 128, HTB = HALF * BK * 2  , STAGE_BYTES = 8 * HTB, NXCD = 8, WGM = 8;

__host__ __device__ __forceinline__ int lds_byte(int r, int c) { const int st = (r >> 4) * 2 + (c >> 5), rr = r & 15, cc = c & 31, ob = rr * 64 + cc * 2; return st * 1024 + (ob ^ (((ob >> 9) & 1) << 5)); }
__host__ __device__ __forceinline__ void stage_rc(int b, int& R, int& C) { const int st = b / 1024, sb = b % 1024, swz = sb ^ (((sb >> 9) & 1) << 5); R = (st >> 1) * 16 + swz / 64; C = (st & 1) * 32 + (swz % 64) / 2; }
__host__ __device__ __forceinline__ int perm32(int rho) { const int n = rho >> 4, i = rho & 15; return 8 * (i >> 2) + 4 * n + (i & 3); }

struct Unit { int pm, pn; };
struct Gemm { const bf16_t* A; const bf16_t* Bt; int M, N, K; };

struct StaticOrder {
    int nM, nN, nwg, G, c;
    __host__ __device__ void init(int M, int N, int G_, int c_) { nM = M / BM; nN = N / BM; nwg = nM * nN; G = G_; c = c_; }
    __host__ __device__ bool next(int i, Unit& u) const {
        const long L = (long)i * G + c; if (L >= nwg) return false;
        int wgid = (int)L; { const int q = nwg / NXCD, r = nwg % NXCD, xcd = wgid % NXCD, off = wgid / NXCD; wgid = (xcd < r ? xcd * (q + 1) : r * (q + 1) + (xcd - r) * q) + off; }
        const int nig = WGM * nN, gid = wgid / nig, fm = gid * WGM, gsz = (nM - fm) < WGM ? (nM - fm) : WGM;
        u.pm = fm + ((wgid % nig) % gsz); u.pn = (wgid % nig) / gsz; return true;
    }
    __device__ __forceinline__ void a_ready(const Unit&) const {}
    __device__ __forceinline__ void done(const Unit&) const {}
};
__device__ __forceinline__ unsigned cvt_pk_bf16(float lo, float hi) { unsigned r; asm volatile("v_cvt_pk_bf16_f32 %0, %1, %2" : "=v"(r) : "v"(lo), "v"(hi)); return r; }
__device__ __forceinline__ float sigmoid_f(float x) { return __builtin_amdgcn_rcpf(1.0f + __expf(-x)); }
__device__ __forceinline__ float silu_f(float x) { return x * sigmoid_f(x); }
__device__ __forceinline__ u32x4 pack8(const f32x4 a, const f32x4 b) { u32x4 w; w.x = cvt_pk_bf16(a[0], a[1]); w.y = cvt_pk_bf16(a[2], a[3]); w.z = cvt_pk_bf16(b[0], b[1]); w.w = cvt_pk_bf16(b[2], b[3]); return w; }

struct EpiPlain {
    static constexpr bool PERM = true, AFTER_DRAIN = false;
    bf16_t* O; int ldc;
    __device__ __forceinline__ void operator()(const f32x4 (&acc)[2][2][4][2], const Unit& u, int wr, int wc, int fr, int fq) const {
        const int row0 = u.pm * BM + wr * 64 + fr, col0 = u.pn * BM + wc * 32 + 8 * fq;
#pragma unroll
        for (int ai = 0; ai < 2; ++ai)
#pragma unroll
            for (int m = 0; m < 4; ++m) { bf16_t* rowp = O + (size_t)(row0 + ai * HALF + m * 16) * ldc + col0;
#pragma unroll
                for (int bj = 0; bj < 2; ++bj) *(u32x4*)(rowp + bj * HALF) = pack8(acc[ai][bj][m][0], acc[ai][bj][m][1]); }
    }
};
struct EpiSwiGLU {
    static constexpr bool PERM = true, AFTER_DRAIN = false;
    bf16_t* O; int ldc;
    __device__ __forceinline__ void operator()(const f32x4 (&acc)[2][2][4][2], const Unit& u, int wr, int wc, int fr, int fq) const {
        const int row0 = u.pm * BM + wr * 64 + fr, col0 = u.pn * HALF + wc * 32 + 8 * fq;
#pragma unroll
        for (int ai = 0; ai < 2; ++ai)
#pragma unroll
            for (int m = 0; m < 4; ++m) { bf16_t* rowp = O + (size_t)(row0 + ai * HALF + m * 16) * ldc + col0;
                f32x4 h0, h1;
#pragma unroll
                for (int j = 0; j < 4; ++j) { h0[j] = silu_f(acc[ai][0][m][0][j]) * acc[ai][1][m][0][j]; h1[j] = silu_f(acc[ai][0][m][1][j]) * acc[ai][1][m][1][j]; }
                *(u32x4*)rowp = pack8(h0, h1); }
    }
};
struct EpiHgProj {
    static constexpr bool PERM = true, AFTER_DRAIN = false;
    bf16_t* O; int ldc; const float* lb;
    __device__ __forceinline__ void operator()(const f32x4 (&acc)[2][2][4][2], const Unit& u, int wr, int wc, int fr, int fq) const {
        const int row0 = u.pm * BM + wr * 64 + fr, col0 = u.pn * BM + wc * 32 + 8 * fq, seg = u.pn >> 3;
        f32x4 lbv[2][2];
#pragma unroll
        for (int bj = 0; bj < 2; ++bj)
#pragma unroll
            for (int n = 0; n < 2; ++n) lbv[bj][n] = (seg == 1) ? *(const f32x4*)(lb + (col0 - 2048) + bj * HALF + 4 * n) : (f32x4){0.f, 0.f, 0.f, 0.f};
#pragma unroll
        for (int ai = 0; ai < 2; ++ai)
#pragma unroll
            for (int m = 0; m < 4; ++m) { bf16_t* rowp = O + (size_t)(row0 + ai * HALF + m * 16) * ldc + col0;
#pragma unroll
                for (int bj = 0; bj < 2; ++bj) { f32x4 v[2] = {acc[ai][bj][m][0], acc[ai][bj][m][1]};
                    if (seg == 0) {
#pragma unroll
                        for (int n = 0; n < 2; ++n)
#pragma unroll
                            for (int j = 0; j < 4; ++j) v[n][j] = silu_f(v[n][j]);
                    } else if (seg == 1) {
#pragma unroll
                        for (int n = 0; n < 2; ++n)
#pragma unroll
                            for (int j = 0; j < 4; ++j) { const float l = lbv[bj][n][j]; v[n][j] = __logf(l + (1.0f - l) * sigmoid_f(v[n][j])); }
                    } else if (seg == 3) {
#pragma unroll
                        for (int n = 0; n < 2; ++n)
#pragma unroll
                            for (int j = 0; j < 4; ++j) v[n][j] = sigmoid_f(v[n][j]);
                    }
                    *(u32x4*)(rowp + bj * HALF) = pack8(v[0], v[1]); } }
    }
};
struct EpiGdnProj {
    static constexpr bool PERM = true, AFTER_DRAIN = false;
    bf16_t* O; int ldc;
    __device__ __forceinline__ void operator()(const f32x4 (&acc)[2][2][4][2], const Unit& u, int wr, int wc, int fr, int fq) const {
        const int row0 = u.pm * BM + wr * 64 + fr, col0 = u.pn * BM + wc * 32 + 8 * fq; const bool isz = u.pn >= 32;
#pragma unroll
        for (int ai = 0; ai < 2; ++ai)
#pragma unroll
            for (int m = 0; m < 4; ++m) { bf16_t* rowp = O + (size_t)(row0 + ai * HALF + m * 16) * ldc + col0;
#pragma unroll
                for (int bj = 0; bj < 2; ++bj) { f32x4 v[2] = {acc[ai][bj][m][0], acc[ai][bj][m][1]};
                    if (isz) {
#pragma unroll
                        for (int n = 0; n < 2; ++n)
#pragma unroll
                            for (int j = 0; j < 4; ++j) v[n][j] = silu_f(v[n][j]);
                    }
                    *(u32x4*)(rowp + bj * HALF) = pack8(v[0], v[1]); } }
    }
};

template <class Epi, class Sched, bool ALIGN_EPI = false, bool SP2 = false>
__device__ __forceinline__ void gemm_phase(PG8_LAS unsigned char* lds, const Gemm g, const Sched& S, const Epi& E) {
    int tid_ = threadIdx.x; asm volatile("" : "+v"(tid_));
    const int tid = tid_, wid = __builtin_amdgcn_readfirstlane(tid >> 6), lane = tid & 63, wr = wid >> 2, wc = wid & 3, fr = lane & 15, fq = lane >> 4;
    const int K = g.K, nt = K / BK;
    unsigned voffA[2], voffB[2];
#pragma unroll
    for (int i = 0; i < 2; ++i) { int R, C; stage_rc(tid * 16 + i * 8192, R, C); const int Rb = Epi::PERM ? ((R & ~31) + perm32(R & 31)) : R;
        voffA[i] = (unsigned)(R * K + C) * 2u; voffB[i] = (unsigned)(Rb * K + C) * 2u; }
    const size_t kstep = (size_t)(BK * 2);
    const size_t hstep = (size_t)HALF * K * 2;
    const size_t tstep = 2 * hstep;
    const unsigned ldsw = (unsigned)wid * 1024u;
    const int aoff = lds_byte(wr * 64 + fr, fq * 8), boff = lds_byte(wc * 32 + fr, fq * 8);
#define PG8_SA(b, h) (((b) * 2 + (h)) * HTB)
#define PG8_SB(b, h) ((4 + (b) * 2 + (h)) * HTB)
#define PG8_STAGE(bufoff, gbase, voff) do { _Pragma("unroll") for (int _i = 0; _i < 2; ++_i) \
        __builtin_amdgcn_global_load_lds((const unsigned*)((const char*)(gbase) + (voff)[_i]), (PG8_LAS unsigned*)(lds + (bufoff) + ldsw + _i * 8192), 16, 0, 0); } while (0)
#define PG8_LDA(dst, b, h) do { _Pragma("unroll") for (int m = 0; m < 4; ++m) _Pragma("unroll") for (int k = 0; k < 2; ++k) dst[m][k] = *(const PG8_LAS bf16x8*)(lds + PG8_SA(b, h) + aoff + m * 2048 + k * 1024); } while (0)
#define PG8_LDB(dst, b, h) do { _Pragma("unroll") for (int n = 0; n < 2; ++n) _Pragma("unroll") for (int k = 0; k < 2; ++k) dst[n][k] = *(const PG8_LAS bf16x8*)(lds + PG8_SB(b, h) + boff + n * 2048 + k * 1024); } while (0)
#define PG8_MMA(ai, bj, At, Bt) do { __builtin_amdgcn_s_setprio(1); _Pragma("unroll") for (int m = 0; m < 4; ++m) _Pragma("unroll") for (int n = 0; n < 2; ++n) _Pragma("unroll") for (int k = 0; k < 2; ++k) \
        acc[ai][bj][m][n] = __builtin_amdgcn_mfma_f32_16x16x32_bf16(Bt[n][k], At[m][k], acc[ai][bj][m][n], 0, 0, 0); __builtin_amdgcn_s_setprio(0); } while (0)
#define PG8_WAIT_V(n) asm volatile("s_waitcnt vmcnt(" #n ")" ::: "memory")
#define PG8_WAIT_L(n) asm volatile("s_waitcnt lgkmcnt(" #n ")" ::: "memory")
#define PG8_BAR __builtin_amdgcn_s_barrier()
#define PG8_SCHED __builtin_amdgcn_sched_barrier(0)
    Unit cur, nxt; int ui = 0;
    if (!S.next(0, cur)) return;
    f32x4 acc[2][2][4][2];
#pragma unroll
    for (int a = 0; a < 2; ++a)
#pragma unroll
        for (int b = 0; b < 2; ++b)
#pragma unroll
            for (int m = 0; m < 4; ++m)
#pragma unroll
                for (int n = 0; n < 2; ++n) acc[a][b][m][n] = (f32x4){0.f, 0.f, 0.f, 0.f};
    bf16x8 At[4][2], B0[2][2], B1[2][2];
    const char* cA = (const char*)g.A + (size_t)cur.pm * tstep; const char* cB = (const char*)g.Bt + (size_t)cur.pn * tstep;
    S.a_ready(cur);
    if constexpr (SP2) {
        PG8_STAGE(PG8_SB(0, 0), cB, voffB); PG8_STAGE(PG8_SB(0, 1), cB + hstep, voffB); PG8_STAGE(PG8_SA(0, 0), cA, voffA); PG8_STAGE(PG8_SA(0, 1), cA + hstep, voffA);
        if (wr == 1) PG8_BAR;
        PG8_WAIT_V(2); PG8_BAR;
        PG8_STAGE(PG8_SB(1, 0), cB + kstep, voffB); PG8_STAGE(PG8_SA(1, 0), cA + kstep, voffA); PG8_STAGE(PG8_SB(1, 1), cB + hstep + kstep, voffB);
        PG8_WAIT_V(6); PG8_BAR;
    } else {
        PG8_STAGE(PG8_SB(0, 0), cB, voffB); PG8_STAGE(PG8_SA(0, 0), cA, voffA); PG8_STAGE(PG8_SB(0, 1), cB + hstep, voffB); PG8_STAGE(PG8_SA(0, 1), cA + hstep, voffA);
        if (wr == 1) PG8_BAR;
        PG8_WAIT_V(4); PG8_BAR;
        PG8_STAGE(PG8_SB(1, 0), cB + kstep, voffB); PG8_STAGE(PG8_SA(1, 0), cA + kstep, voffA); PG8_STAGE(PG8_SB(1, 1), cB + hstep + kstep, voffB);
        PG8_WAIT_V(6); PG8_BAR;
    }
    for (;;) {
        const bool has_next = S.next(ui + 1, nxt);
        const char* nA = has_next ? (const char*)g.A + (size_t)nxt.pm * tstep : cA; const char* nB = has_next ? (const char*)g.Bt + (size_t)nxt.pn * tstep : cB;
        for (int t = 0; t < nt; t += 2) {
            const bool last = (t == nt - 2);
            const char* a1 = cA + (size_t)(t + 1) * kstep;
            const char* a2 = last ? nA : cA + (size_t)(t + 2) * kstep; const char* b2 = last ? nB : cB + (size_t)(t + 2) * kstep;
            const char* a3 = a2 + kstep; const char* b3 = b2 + kstep;
            if (last && has_next) S.a_ready(nxt);
            if constexpr (SP2) {
            PG8_LDB(B0, 0, 0); PG8_LDB(B1, 0, 1); PG8_SCHED; PG8_LDA(At, 0, 0); PG8_STAGE(PG8_SA(1, 1), a1 + hstep, voffA);
            PG8_WAIT_V(8); PG8_WAIT_L(0); PG8_BAR; PG8_MMA(0, 0, At, B0); PG8_MMA(0, 1, At, B1); PG8_BAR; PG8_SCHED;
            PG8_LDA(At, 0, 1); PG8_STAGE(PG8_SB(0, 0), b2, voffB); PG8_STAGE(PG8_SB(0, 1), b2 + hstep, voffB); PG8_STAGE(PG8_SA(0, 0), a2, voffA);
            PG8_WAIT_V(8); PG8_WAIT_L(0); PG8_BAR; PG8_MMA(1, 0, At, B0); PG8_MMA(1, 1, At, B1); PG8_BAR; PG8_SCHED;
            PG8_LDB(B0, 1, 0); PG8_LDB(B1, 1, 1); PG8_SCHED; PG8_LDA(At, 1, 0); PG8_STAGE(PG8_SA(0, 1), a2 + hstep, voffA);
            PG8_WAIT_V(8); PG8_WAIT_L(0); PG8_BAR; PG8_MMA(0, 0, At, B0); PG8_MMA(0, 1, At, B1); PG8_BAR; PG8_SCHED;
            PG8_LDA(At, 1, 1); PG8_STAGE(PG8_SB(1, 0), b3, voffB); PG8_STAGE(PG8_SB(1, 1), b3 + hstep, voffB); PG8_STAGE(PG8_SA(1, 0), a3, voffA);
            PG8_WAIT_V(8); PG8_WAIT_L(0); PG8_BAR; PG8_MMA(1, 0, At, B0); PG8_MMA(1, 1, At, B1); PG8_BAR; PG8_SCHED;
            } else {
            PG8_LDB(B0, 0, 0); PG8_SCHED; PG8_LDA(At, 0, 0); PG8_STAGE(PG8_SA(1, 1), a1 + hstep, voffA);
            PG8_WAIT_L(8); PG8_BAR; PG8_WAIT_L(0); PG8_MMA(0, 0, At, B0); PG8_BAR; PG8_SCHED;
            PG8_LDB(B1, 0, 1); PG8_STAGE(PG8_SB(0, 0), b2, voffB);
            PG8_BAR; PG8_WAIT_L(0); PG8_MMA(0, 1, At, B1); PG8_BAR;
            PG8_LDA(At, 0, 1); PG8_STAGE(PG8_SA(0, 0), a2, voffA);
            PG8_BAR; PG8_WAIT_L(0); PG8_MMA(1, 0, At, B0); PG8_BAR; PG8_SCHED;
            PG8_STAGE(PG8_SB(0, 1), b2 + hstep, voffB);
            PG8_WAIT_V(6); PG8_BAR; PG8_MMA(1, 1, At, B1); PG8_BAR;
            PG8_LDB(B0, 1, 0); PG8_SCHED; PG8_LDA(At, 1, 0); PG8_STAGE(PG8_SA(0, 1), a2 + hstep, voffA);
            PG8_WAIT_L(8); PG8_BAR; PG8_WAIT_L(0); PG8_MMA(0, 0, At, B0); PG8_BAR; PG8_SCHED;
            PG8_LDB(B1, 1, 1); PG8_STAGE(PG8_SB(1, 0), b3, voffB);
            PG8_BAR; PG8_WAIT_L(0); PG8_MMA(0, 1, At, B1); PG8_BAR;
            PG8_LDA(At, 1, 1); PG8_STAGE(PG8_SA(1, 0), a3, voffA);
            PG8_BAR; PG8_WAIT_L(0); PG8_MMA(1, 0, At, B0); PG8_BAR; PG8_SCHED;
            PG8_STAGE(PG8_SB(1, 1), b3 + hstep, voffB);
            PG8_WAIT_V(6); PG8_BAR; PG8_MMA(1, 1, At, B1); PG8_BAR;
            }
        }
        if constexpr (ALIGN_EPI) { if (wr == 0) PG8_BAR; }
        if constexpr (!Epi::AFTER_DRAIN) { E(acc, cur, wr, wc, fr, fq); S.done(cur); }
        if (!has_next) break;
#pragma unroll
        for (int a = 0; a < 2; ++a)
#pragma unroll
            for (int b = 0; b < 2; ++b)
#pragma unroll
                for (int m = 0; m < 4; ++m)
#pragma unroll
                    for (int n = 0; n < 2; ++n) acc[a][b][m][n] = (f32x4){0.f, 0.f, 0.f, 0.f};
        cur = nxt; cA = nA; cB = nB; ++ui;
        if constexpr (ALIGN_EPI) { if (wr == 1) PG8_BAR; }
    }
    PG8_WAIT_V(0);
    if constexpr (!ALIGN_EPI) { if (wr == 0) PG8_BAR; }
    PG8_BAR;
    if constexpr (Epi::AFTER_DRAIN) { E.fused(acc, cur, wr, wc, fr, fq, lds, wid, lane); S.done(cur); }
#undef PG8_SA
#undef PG8_SB
#undef PG8_STAGE
#undef PG8_LDA
#undef PG8_LDB
#undef PG8_MMA
#undef PG8_WAIT_V
#undef PG8_WAIT_L
#undef PG8_BAR
#undef PG8_SCHED
}
}
#ifndef PG8_SP2
#define PG8_SP2 true
#endif
#ifndef PG8_ALIGN
#define PG8_ALIGN true
#endif
#ifndef MK_N_LAUNCHES
#define MK_N_LAUNCHES 0
#endif

constexpr int NWAVES = 8;
constexpr int DM = 2048, NBATCH = 16, SEQ = 2048, MTOK = NBATCH * SEQ, DEPTH = 4;
constexpr int HG_IN = 8192, GDN_IN = 12352, GDN_MAIN = 12288, FFH = 5632, GU = 2 * FFH, NMOD = 6 * DM, GDN_VAL = 4096;
constexpr float EPS = 1e-6f;
constexpr int N_PHASES = 2 + 4 * 8;

constexpr size_t MiB = 1u << 20;
constexpr size_t WS_CTL = 0, CTL_ZERO_BYTES = 1 * MiB;
constexpr size_t WS_MODP = 1 * MiB;
constexpr size_t WS_LB = 13 * MiB;
constexpr size_t WS_BG = 14 * MiB;
constexpr size_t WS_W = 24 * MiB;
constexpr size_t W_HGIN = WS_W, W_HGIN_SZ = (size_t)HG_IN * DM * 2;
constexpr size_t W_HGOUT = W_HGIN + 2 * W_HGIN_SZ, W_HGOUT_SZ = (size_t)DM * DM * 2;
constexpr size_t W_GDNIN = W_HGOUT + 2 * W_HGOUT_SZ, W_GDNIN_SZ = (size_t)GDN_IN * DM * 2;
constexpr size_t W_GDNOUT = W_GDNIN + 2 * W_GDNIN_SZ, W_GDNOUT_SZ = (size_t)DM * GDN_VAL * 2;
constexpr size_t W_GU = W_GDNOUT + 2 * W_GDNOUT_SZ, W_GU_SZ = (size_t)GU * DM * 2;
constexpr size_t W_DOWN = W_GU + 4 * W_GU_SZ, W_DOWN_SZ = (size_t)DM * FFH * 2;
constexpr size_t W_END = W_DOWN + 4 * W_DOWN_SZ;
constexpr size_t WS_HO = 500 * MiB;
constexpr size_t WS_P = 756 * MiB;
constexpr size_t WS_Y = WS_P + 512 * MiB;
constexpr size_t WS_END = WS_P + 768 * MiB;
static_assert(W_END <= WS_HO, "weights overflow");
static_assert((size_t)MTOK * FFH * 2 <= 512 * MiB, "hidden must not reach y");

constexpr int RING_BYTES = 131072;
constexpr int LDSCTL_OFF = RING_BYTES, MISC_OFF = LDSCTL_OFF + 320;
constexpr int LDS_BYTES = 147456;

#define GAS __attribute__((address_space(1)))
#define LAS __attribute__((address_space(3)))
typedef unsigned short bf16;
typedef unsigned v4u __attribute__((ext_vector_type(4)));
typedef unsigned v2u __attribute__((ext_vector_type(2)));
typedef float f32x4 __attribute__((ext_vector_type(4)));
typedef short bf16x8 __attribute__((ext_vector_type(8)));
typedef GAS unsigned gu32;
#define RLX_AGENT __ATOMIC_RELAXED, __HIP_MEMORY_SCOPE_AGENT
#define LDS_WAIT() asm volatile("s_waitcnt lgkmcnt(0)" ::: "memory")
#define VM_WAIT() asm volatile("s_waitcnt vmcnt(0)" ::: "memory")
__device__ __forceinline__ unsigned f2bf(float f) { unsigned u = __builtin_bit_cast(unsigned, f); return (u + 0x7fffu + ((u >> 16) & 1u)) >> 16; }
__device__ __forceinline__ unsigned pk2(float lo, float hi) { return f2bf(lo) | (f2bf(hi) << 16); }
__device__ __forceinline__ float bflo(unsigned w) { return __builtin_bit_cast(float, w << 16); }
__device__ __forceinline__ float bfhi(unsigned w) { return __builtin_bit_cast(float, w & 0xffff0000u); }
__device__ __forceinline__ float bf1(unsigned short h) { return __builtin_bit_cast(float, ((unsigned)h) << 16); }
__device__ __forceinline__ float wave_sum(float v) {
#pragma unroll
    for (int o = 1; o < 64; o <<= 1) v += __shfl_xor(v, o);
    return v;
}
__device__ __forceinline__ float quad_sum(float x) {
    int xi = __builtin_bit_cast(int, x);
    x += __builtin_bit_cast(float, __builtin_amdgcn_update_dpp(xi, xi, 0xB1, 0xf, 0xf, false));
    xi = __builtin_bit_cast(int, x);
    x += __builtin_bit_cast(float, __builtin_amdgcn_update_dpp(xi, xi, 0x4E, 0xf, 0xf, false));
    return x;
}
__device__ __forceinline__ float sigm(float x) { return __builtin_amdgcn_rcpf(1.0f + __expf(-x)); }

#define XB_TMO      128
#define XB_XCNT(j)  (256  + 64 * (j))
#define XB_XSUB(j)  (1280 + 64 * (j))
#define XB_XGEN(j)  (2304 + 64 * (j))
#define XB_TOP      3328
#define XB_TOPGEN   3392
#define XCD_BAR_WORDS 3456
#define XB_SPIN_CAP (1u << 18)

__device__ __forceinline__ unsigned xb_ld(unsigned* p)              { return __hip_atomic_load(p, __ATOMIC_RELAXED, __HIP_MEMORY_SCOPE_AGENT); }
__device__ __forceinline__ unsigned xb_add(unsigned* p, unsigned v) { return __hip_atomic_fetch_add(p, v, __ATOMIC_RELAXED, __HIP_MEMORY_SCOPE_AGENT); }
__device__ __forceinline__ unsigned xb_xcc_id() { return (unsigned)__builtin_amdgcn_s_getreg((3 << 11) | 20) & 0xFu; }
#define XB_SPIN(cond, bar) do { unsigned _sp = 0; while (cond) { __builtin_amdgcn_s_sleep(1); \
    if ((++_sp & 255u) == 0u) { if (xb_ld(&(bar)[XB_TMO])) break; if (_sp > XB_SPIN_CAP) { atomicAdd(&(bar)[XB_TMO], 1u); break; } } } } while (0)

struct XcdBarrier {
    unsigned* bar; unsigned x;
    volatile LAS unsigned* st;
};

__device__ __forceinline__ XcdBarrier xcd_barrier_post(unsigned* bar, volatile LAS unsigned* st) {
    XcdBarrier b; b.bar = bar; b.x = xb_xcc_id(); b.st = st;
    if (threadIdx.x == 0) (void)xb_add(&bar[XB_XCNT(b.x)], 1u);
    return b;
}
__device__ __forceinline__ void xcd_barrier_complete(unsigned* bar, unsigned x, unsigned& nloc, unsigned& nx) {
    const unsigned G = gridDim.x * gridDim.y * gridDim.z;
    unsigned sum, cnt, mine, sp = 0u;
    for (;;) {
        sum = 0u; cnt = 0u; mine = 0u;
#pragma unroll
        for (unsigned j = 0; j < 16; ++j) { const unsigned c = xb_ld(&bar[XB_XCNT(j)]); sum += c; cnt += (c > 0u) ? 1u : 0u; mine = (j == x) ? c : mine; }
        if (sum == G) break;
        __builtin_amdgcn_s_sleep(1);
        if ((++sp & 255u) == 0u) { if (xb_ld(&bar[XB_TMO])) break; if (sp > XB_SPIN_CAP) { atomicAdd(&bar[XB_TMO], 1u); break; } }
    }
    nloc = mine > 0u ? mine : 1u; nx = cnt > 0u ? cnt : 1u;
}

__device__ __forceinline__ void xcd_barrier(const XcdBarrier& b) {
    asm volatile("s_waitcnt vmcnt(0)" ::: "memory");
    __syncthreads();
    if (threadIdx.x == 0) {
        unsigned* bar = b.bar;
        __builtin_amdgcn_s_waitcnt(0);
        unsigned nloc = b.st[0], nx = b.st[1];
        if (nloc == 0u) { xcd_barrier_complete(bar, b.x, nloc, nx); b.st[0] = nloc; b.st[1] = nx; }
        const unsigned old = xb_add(&bar[XB_XSUB(b.x)], 1u);
        const unsigned gen = old / nloc;
        if (old + 1u == (gen + 1u) * nloc) {
            __builtin_amdgcn_fence(__ATOMIC_RELEASE, "agent");
            asm volatile("s_waitcnt vmcnt(0)" ::: "memory");
            const unsigned og = xb_add(&bar[XB_TOP], 1u);
            const unsigned tg = og / nx;
            if (og + 1u == (tg + 1u) * nx) xb_add(&bar[XB_TOPGEN], 1u);
            else XB_SPIN(xb_ld(&bar[XB_TOPGEN]) == tg, bar);
            __builtin_amdgcn_fence(__ATOMIC_ACQUIRE, "agent");
            xb_add(&bar[XB_XGEN(b.x)], 1u);
            asm volatile("s_waitcnt vmcnt(0)" ::: "memory");
        } else {
            XB_SPIN(xb_ld(&bar[XB_XGEN(b.x)]) == gen, bar);
            __builtin_amdgcn_fence(__ATOMIC_ACQUIRE, "agent");
            asm volatile("s_waitcnt vmcnt(0)" ::: "memory");
        }
    }
    __syncthreads();
}
struct Frame {
    LAS unsigned char* lds;
    volatile LAS unsigned* MISC;
    gu32* ctl;
    int tid, lane, wave, G;
    const float *x, *c, *ada_w, *ada_b, *norm_w, *hg_w_in, *hg_lb, *hg_norm_w, *hg_w_out, *gdn_w_in, *gdn_conv_w, *gdn_A_log, *gdn_dt_bias, *gdn_norm_w, *gdn_w_out, *ffn_gu, *ffn_down;
    float* out; unsigned char* ws;
};

__device__ __forceinline__ void p0_mod_task(Frame& F, int task) {
    const int cb = task % 192, kq = task / 192, l = cb / 48, n0 = (cb % 48) * 256;
    LAS float* CA = (LAS float*)F.lds;
    LAS float* RED = (LAS float*)(F.lds + 32768);
    float* modp = (float*)(F.ws + WS_MODP);
    {
        const int k = F.tid;
#pragma unroll
        for (int b = 0; b < 16; ++b) { const float cv = F.c[b * DM + kq * 512 + k]; CA[k * 16 + b] = cv * sigm(cv); }
    }
    __syncthreads();
    f32x4 acc[16];
#pragma unroll
    for (int b = 0; b < 16; ++b) acc[b] = (f32x4){0.f, 0.f, 0.f, 0.f};
    const float* wp = F.ada_w + ((size_t)l * DM + kq * 512 + F.wave * 64) * NMOD + n0 + 4 * F.lane;
#pragma unroll 4
    for (int kk = 0; kk < 64; ++kk) {
        const f32x4 wv = *(const f32x4*)(wp + (size_t)kk * NMOD);
        const LAS f32x4* cp = (const LAS f32x4*)(CA + (F.wave * 64 + kk) * 16);
        const f32x4 c0 = cp[0], c1 = cp[1], c2 = cp[2], c3 = cp[3];
#pragma unroll
        for (int j = 0; j < 4; ++j) { acc[j] += c0[j] * wv; acc[4 + j] += c1[j] * wv; acc[8 + j] += c2[j] * wv; acc[12 + j] += c3[j] * wv; }
    }
#pragma unroll
    for (int p = 0; p < 4; ++p) {
        __syncthreads();
        LAS f32x4* rp = (LAS f32x4*)(RED + (F.wave * 64 + F.lane) * 16);
        rp[0] = acc[4 * p]; rp[1] = acc[4 * p + 1]; rp[2] = acc[4 * p + 2]; rp[3] = acc[4 * p + 3];
        __syncthreads();
#pragma unroll
        for (int e = 0; e < 2; ++e) {
            const int o = F.tid + 512 * e, bi = o >> 8, nn = o & 255, ln = nn >> 2, ci = nn & 3;
            float s = 0.f;
#pragma unroll
            for (int w = 0; w < 8; ++w) s += RED[(w * 64 + ln) * 16 + bi * 4 + ci];
            modp[(((size_t)kq * 4 + l) * 16 + (4 * p + bi)) * NMOD + n0 + nn] = s;
        }
    }
    __syncthreads();
}
__device__ __forceinline__ void transpose_item(const float* W, int K, int N, bf16* WT, int rowb, int k0, int n0, LAS float* scr, int lane) {
#pragma unroll 8
    for (int i = 0; i < 32; ++i) { const int kk = 2 * i + (lane >> 5); scr[kk * 33 + (lane & 31)] = W[(size_t)(k0 + kk) * N + n0 + (lane & 31)]; }
    LDS_WAIT(); asm volatile("" ::: "memory");
    const int c = lane & 7;
#pragma unroll
    for (int j = 0; j < 4; ++j) { const int n = (lane >> 3) + 8 * j; const LAS float* s = scr + (8 * c) * 33 + n;
        v4u o; o.x = pk2(s[0 * 33], s[1 * 33]); o.y = pk2(s[2 * 33], s[3 * 33]); o.z = pk2(s[4 * 33], s[5 * 33]); o.w = pk2(s[6 * 33], s[7 * 33]);
        *(GAS v4u*)(WT + (size_t)(rowb + n) * K + k0 + 8 * c) = o; }
    LDS_WAIT(); asm volatile("" ::: "memory");
}
constexpr int I_HGIN = (DM / 64) * (HG_IN / 32), I_HGOUT = (DM / 64) * (DM / 32), I_GDNIN = (DM / 64) * (GDN_IN / 32), I_GDNOUT = (GDN_VAL / 64) * (DM / 32), I_GU = (DM / 64) * (GU / 32), I_DOWN = (FFH / 64) * (DM / 32);
constexpr int NITEMS = 2 * I_HGIN + 2 * I_HGOUT + 2 * I_GDNIN + 2 * I_GDNOUT + 4 * I_GU + 4 * I_DOWN;
__device__ __forceinline__ void p0_prologue(Frame& F) {
    for (int task = blockIdx.x; task < 768; task += F.G) p0_mod_task(F, task);
    if (blockIdx.x == 0) {
        float* lb = (float*)(F.ws + WS_LB);
        for (int n = F.tid; n < 2048; n += 512) { const float l0 = F.hg_lb[n], l1 = F.hg_lb[2048 + n]; lb[n] = 0.f; lb[2048 + n] = 1.0f / (1.0f + expf(l0 - l1)); }
    }
    LAS float* scr = (LAS float*)(F.lds + F.wave * 16384);
    const int gw = blockIdx.x * NWAVES + F.wave, NGW = F.G * NWAVES;
    for (int it = gw; it < NITEMS; it += NGW) {
        int r = it, K, N, mode = 0; const float* W; bf16* WT;
        if (r < 2 * I_HGIN) { const int j = r / I_HGIN; r -= j * I_HGIN; W = F.hg_w_in + (size_t)j * DM * HG_IN; WT = (bf16*)(F.ws + W_HGIN + j * W_HGIN_SZ); K = DM; N = HG_IN; }
        else if ((r -= 2 * I_HGIN) < 2 * I_HGOUT) { const int j = r / I_HGOUT; r -= j * I_HGOUT; W = F.hg_w_out + (size_t)j * DM * DM; WT = (bf16*)(F.ws + W_HGOUT + j * W_HGOUT_SZ); K = DM; N = DM; }
        else if ((r -= 2 * I_HGOUT) < 2 * I_GDNIN) { const int j = r / I_GDNIN; r -= j * I_GDNIN; W = F.gdn_w_in + (size_t)j * DM * GDN_IN; WT = (bf16*)(F.ws + W_GDNIN + j * W_GDNIN_SZ); K = DM; N = GDN_IN; }
        else if ((r -= 2 * I_GDNIN) < 2 * I_GDNOUT) { const int j = r / I_GDNOUT; r -= j * I_GDNOUT; W = F.gdn_w_out + (size_t)j * GDN_VAL * DM; WT = (bf16*)(F.ws + W_GDNOUT + j * W_GDNOUT_SZ); K = GDN_VAL; N = DM; }
        else if ((r -= 2 * I_GDNOUT) < 4 * I_GU) { const int j = r / I_GU; r -= j * I_GU; W = F.ffn_gu + (size_t)j * DM * GU; WT = (bf16*)(F.ws + W_GU + j * W_GU_SZ); K = DM; N = GU; mode = 1; }
        else { r -= 4 * I_GU; const int j = r / I_DOWN; r -= j * I_DOWN; W = F.ffn_down + (size_t)j * FFH * DM; WT = (bf16*)(F.ws + W_DOWN + j * W_DOWN_SZ); K = FFH; N = DM; }
        const int nblk = N / 32, kb = r / nblk, nb = r % nblk, k0 = 64 * kb, n0 = 32 * nb;
        int rowb = n0;
        if (mode == 1) rowb = (n0 < FFH) ? 256 * (n0 / 128) + (n0 % 128) : 256 * ((n0 - FFH) / 128) + 128 + ((n0 - FFH) % 128);
        transpose_item(W, K, N, WT, rowb, k0, n0, scr, F.lane);
    }
}

__device__ __forceinline__ f32x4 modval(const float* modp, const float* ada_b, int l, int b, int off) {
    f32x4 s = *(const f32x4*)(ada_b + (size_t)l * NMOD + off);
#pragma unroll
    for (int kq = 0; kq < 4; ++kq) s += *(const f32x4*)(modp + (((size_t)kq * 4 + l) * 16 + b) * NMOD + off);
    return s;
}
__device__ __forceinline__ void row_pass(Frame& F, const float* xin, const bf16* y, float* xout, bf16* hout, int lg, int gchunk, int wyi, int lh, int scchunk, int shchunk, int whi) {
    LAS float* GW = (LAS float*)F.lds; LAS float* WSv = GW + 2048; LAS float* SH = GW + 4096;
    const float* modp = (const float*)(F.ws + WS_MODP);
    for (int rb = blockIdx.x; rb < MTOK / 128; rb += F.G) {
        const int b = rb >> 4;
        __syncthreads();
        {
            const int n = 4 * F.tid;
            if (y) { const f32x4 g = modval(modp, F.ada_b, lg, b, gchunk * DM + n); const f32x4 w = *(const f32x4*)(F.norm_w + (size_t)(lg * 4 + wyi) * DM + n); *(LAS f32x4*)(GW + n) = g * w; }
            if (hout) { const f32x4 sc = modval(modp, F.ada_b, lh, b, scchunk * DM + n), sh = modval(modp, F.ada_b, lh, b, shchunk * DM + n); const f32x4 w = *(const f32x4*)(F.norm_w + (size_t)(lh * 4 + whi) * DM + n);
                *(LAS f32x4*)(WSv + n) = w * (sc + 1.0f); *(LAS f32x4*)(SH + n) = sh; }
        }
        __syncthreads();
        for (int i = 0; i < 16; ++i) {
            const size_t row = (size_t)rb * 128 + F.wave + 8 * i;
            const f32x4* xr = (const f32x4*)(xin + row * DM) + F.lane;
            f32x4 xv[8];
#pragma unroll
            for (int j = 0; j < 8; ++j) xv[j] = xr[64 * j];
            if (y) {
                const v2u* yr = (const v2u*)(y + row * DM) + F.lane;
                f32x4 yv[8]; float ss = 0.f;
#pragma unroll
                for (int j = 0; j < 8; ++j) { const v2u w = yr[64 * j]; yv[j] = (f32x4){bflo(w.x), bfhi(w.x), bflo(w.y), bfhi(w.y)}; ss += (yv[j][0] * yv[j][0] + yv[j][1] * yv[j][1]) + (yv[j][2] * yv[j][2] + yv[j][3] * yv[j][3]); }
                const float ry = rsqrtf(wave_sum(ss) * (1.0f / DM) + EPS);
                f32x4* xo = (f32x4*)(xout + row * DM) + F.lane;
#pragma unroll
                for (int j = 0; j < 8; ++j) { const f32x4 g = *(const LAS f32x4*)(GW + 4 * F.lane + 256 * j); xv[j] += g * (yv[j] * ry); xo[64 * j] = xv[j]; }
            }
            if (hout) {
                float ss = 0.f;
#pragma unroll
                for (int j = 0; j < 8; ++j) ss += (xv[j][0] * xv[j][0] + xv[j][1] * xv[j][1]) + (xv[j][2] * xv[j][2] + xv[j][3] * xv[j][3]);
                const float rx = rsqrtf(wave_sum(ss) * (1.0f / DM) + EPS);
                v2u* ho = (v2u*)(hout + row * DM) + F.lane;
#pragma unroll
                for (int j = 0; j < 8; ++j) { const f32x4 w = *(const LAS f32x4*)(WSv + 4 * F.lane + 256 * j), s = *(const LAS f32x4*)(SH + 4 * F.lane + 256 * j);
                    const f32x4 hv = xv[j] * rx * w + s; v2u o; o.x = pk2(hv[0], hv[1]); o.y = pk2(hv[2], hv[3]); ho[64 * j] = o; }
            }
        }
    }
}

__device__ __forceinline__ void gdn_tail(Frame& F, const bf16* H, const bf16* WT, const float* A_log, const float* dt_bias, float* BG) {
    const int gw = blockIdx.x * NWAVES + F.wave, NGW = F.G * NWAVES, r16 = F.lane & 15, g = F.lane >> 4;
    for (int tile = gw; tile < MTOK / 16; tile += NGW) {
        const int row0 = tile * 16;
        f32x4 acc[4];
#pragma unroll
        for (int nt = 0; nt < 4; ++nt) acc[nt] = (f32x4){0.f, 0.f, 0.f, 0.f};
        const bf16* ap = H + (size_t)(row0 + r16) * DM + 8 * g;
        const bf16* bp = WT + (size_t)r16 * DM + 8 * g;
#pragma unroll 4
        for (int kk = 0; kk < DM / 32; ++kk) {
            const bf16x8 a = *(const bf16x8*)(ap + 32 * kk);
#pragma unroll
            for (int nt = 0; nt < 4; ++nt) { const bf16x8 bb = *(const bf16x8*)(bp + (size_t)nt * 16 * DM + 32 * kk); acc[nt] = __builtin_amdgcn_mfma_f32_16x16x32_bf16(a, bb, acc[nt], 0, 0, 0); }
        }
#pragma unroll
        for (int nt = 0; nt < 4; ++nt)
#pragma unroll
            for (int r = 0; r < 4; ++r) {
                const int row = row0 + 4 * g + r, col = nt * 16 + r16; const float v = acc[nt][r]; float o;
                if (nt < 2) o = sigm(v);
                else { const int hd = col - 32; const float xx = v + dt_bias[hd]; const float sp = xx > 20.f ? xx : log1pf(expf(xx)); o = -expf(A_log[hd]) * sp; }
                BG[(size_t)row * 64 + col] = o;
            }
    }
}

__device__ __forceinline__ void hgrn_scan(Frame& F, const bf16* P, bf16* O, const float* normw) {
    LAS float* Fs = (LAS float*)F.lds; LAS float* Qs = Fs + 16 * 144; LAS float* Vs = Qs + 16 * 144; LAS float* Os = Vs + 16 * 128;
    const int t = F.tid, v = t >> 2, kq = t & 3, st = t >> 5, c4 = (t & 31) * 4;
    for (int unit = blockIdx.x; unit < NBATCH * 16; unit += F.G) {
        const int b = unit >> 4, h = unit & 15;
        const bf16* pbase = P + (size_t)(b * SEQ + st) * HG_IN + h * 128 + c4;
        float S[32];
#pragma unroll
        for (int i = 0; i < 32; ++i) S[i] = 0.f;
        const f32x4 nw = *(const f32x4*)(normw + c4);
        v2u rq = *(const v2u*)(pbase), rf = *(const v2u*)(pbase + 2048), rv = *(const v2u*)(pbase + 4096), rg = *(const v2u*)(pbase + 6144);
        __syncthreads();
        for (int c = 0; c < SEQ / 16; ++c) {
            {
                const int o = st * 144 + (c4 >> 5) * 36 + (c4 & 31);
                *(LAS f32x4*)(Fs + o) = (f32x4){__expf(bflo(rf.x)), __expf(bfhi(rf.x)), __expf(bflo(rf.y)), __expf(bfhi(rf.y))};
                *(LAS f32x4*)(Qs + o) = (f32x4){bflo(rq.x), bfhi(rq.x), bflo(rq.y), bfhi(rq.y)};
                *(LAS f32x4*)(Vs + st * 128 + c4) = (f32x4){bflo(rv.x), bfhi(rv.x), bflo(rv.y), bfhi(rv.y)};
            }
            const f32x4 gt = (f32x4){bflo(rg.x), bfhi(rg.x), bflo(rg.y), bfhi(rg.y)};
            __syncthreads();
            if (c + 1 < SEQ / 16) { const bf16* pn = pbase + (size_t)(c + 1) * 16 * HG_IN; rq = *(const v2u*)(pn); rf = *(const v2u*)(pn + 2048); rv = *(const v2u*)(pn + 4096); rg = *(const v2u*)(pn + 6144); }
#pragma unroll
            for (int s = 0; s < 16; ++s) {
                const LAS f32x4* fp = (const LAS f32x4*)(Fs + s * 144 + kq * 36); const LAS f32x4* qp = (const LAS f32x4*)(Qs + s * 144 + kq * 36);
                const float vv = Vs[s * 128 + v];
                float op = 0.f;
#pragma unroll
                for (int i4 = 0; i4 < 8; ++i4) { const f32x4 f4 = fp[i4], q4 = qp[i4];
#pragma unroll
                    for (int j = 0; j < 4; ++j) { S[4 * i4 + j] = fmaf(f4[j], S[4 * i4 + j] - vv, vv); op = fmaf(S[4 * i4 + j], q4[j], op); } }
                op = quad_sum(op);
                if (kq == 0) Os[s * 128 + v] = op;
            }
            __syncthreads();
            {
                const f32x4 o4 = *(const LAS f32x4*)(Os + st * 128 + c4);
                float ss = (o4[0] * o4[0] + o4[1] * o4[1]) + (o4[2] * o4[2] + o4[3] * o4[3]);
#pragma unroll
                for (int m = 1; m < 32; m <<= 1) ss += __shfl_xor(ss, m);
                const float r = rsqrtf(ss * (1.0f / 128.0f) + EPS);
                v2u w; w.x = pk2(o4[0] * r * nw[0] * gt[0], o4[1] * r * nw[1] * gt[1]); w.y = pk2(o4[2] * r * nw[2] * gt[2], o4[3] * r * nw[3] * gt[3]);
                *(v2u*)(O + (size_t)(b * SEQ + c * 16 + st) * DM + h * 128 + c4) = w;
            }
        }
    }
}

__device__ __forceinline__ void gdn_scan(Frame& F, const bf16* P, const float* BG, bf16* O, const float* convw, const float* normw) {
    LAS float* Ks = (LAS float*)F.lds; LAS float* Qs = Ks + 16 * 144; LAS float* V0s = Qs + 16 * 144; LAS float* V1s = V0s + 16 * 128; LAS float* O0s = V1s + 16 * 128; LAS float* O1s = O0s + 16 * 128; LAS float* SC = O1s + 16 * 128;
    const int t = F.tid, v = t >> 2, kq = t & 3, st = t >> 5, c8 = (t & 31) * 8, hh = c8 >> 7, v0i = c8 & 127;
    for (int unit = blockIdx.x; unit < NBATCH * 16; unit += F.G) {
        const int b = unit >> 4, kh = unit & 15;
        const int col = t < 128 ? kh * 128 + t : (t < 256 ? 2048 + kh * 128 + (t - 128) : 4096 + kh * 256 + (t - 256));
        const float cw0 = convw[col], cw1 = convw[8192 + col], cw2 = convw[2 * 8192 + col], cw3 = convw[3 * 8192 + col];
        LAS float* dptr; int dstride;
        if (t < 128) { dptr = Qs + (t >> 5) * 36 + (t & 31); dstride = 144; }
        else if (t < 256) { dptr = Ks + ((t - 128) >> 5) * 36 + (t & 31); dstride = 144; }
        else if (t < 384) { dptr = V0s + (t - 256); dstride = 128; }
        else { dptr = V1s + (t - 384); dstride = 128; }
        float S0[32], S1[32];
#pragma unroll
        for (int i = 0; i < 32; ++i) { S0[i] = 0.f; S1[i] = 0.f; }
        float h0 = 0.f, h1 = 0.f, h2 = 0.f;
        const bf16* pcol = P + (size_t)(b * SEQ) * GDN_MAIN + col;
        unsigned short raw[16];
#pragma unroll
        for (int s = 0; s < 16; ++s) raw[s] = pcol[(size_t)s * GDN_MAIN];
        float bgb = 0.f, bgg = 0.f;
        if (t < 32) { const float* bp = BG + (size_t)(b * SEQ + (t >> 1)) * 64 + 2 * kh + (t & 1); bgb = bp[0]; bgg = bp[32]; }
        const f32x4 nw0 = *(const f32x4*)(normw + v0i), nw1 = *(const f32x4*)(normw + v0i + 4);
        __syncthreads();
        for (int c = 0; c < SEQ / 16; ++c) {
#pragma unroll
            for (int s = 0; s < 16; ++s) { const float xx = bf1(raw[s]); const float yy = cw0 * h0 + cw1 * h1 + cw2 * h2 + cw3 * xx; h0 = h1; h1 = h2; h2 = xx; dptr[s * dstride] = yy * sigm(yy); }
            if (t < 32) { SC[(t >> 1) * 8 + 2 + (t & 1)] = bgb; SC[(t >> 1) * 8 + 4 + (t & 1)] = __expf(bgg); }
            __syncthreads();
#pragma unroll
            for (int e = 0; e < 2; ++e) {
                const int s = 2 * F.wave + e, o1 = s * 144 + (F.lane >> 5) * 36 + (F.lane & 31), o2 = o1 + 72;
                const float qa = Qs[o1], qb = Qs[o2], ka = Ks[o1], kb = Ks[o2];
                const float sq = wave_sum(qa * qa + qb * qb), sk = wave_sum(ka * ka + kb * kb);
                if (F.lane == 0) { SC[s * 8 + 0] = rsqrtf(sq + EPS) * 0.08838834764831845f; SC[s * 8 + 1] = rsqrtf(sk + EPS); }
            }
            __syncthreads();
            if (c + 1 < SEQ / 16) {
#pragma unroll
                for (int s = 0; s < 16; ++s) raw[s] = pcol[(size_t)((c + 1) * 16 + s) * GDN_MAIN];
                if (t < 32) { const float* bp = BG + (size_t)(b * SEQ + (c + 1) * 16 + (t >> 1)) * 64 + 2 * kh + (t & 1); bgb = bp[0]; bgg = bp[32]; }
            }
            const v4u zz = *(const v4u*)(P + (size_t)(b * SEQ + c * 16 + st) * GDN_MAIN + 8192 + (2 * kh + hh) * 128 + v0i);
#pragma unroll
            for (int s = 0; s < 16; ++s) {
                const f32x4 sA = *(const LAS f32x4*)(SC + s * 8), sB = *(const LAS f32x4*)(SC + s * 8 + 4);
                const float rq = sA[0], rk = sA[1], b0 = sA[2], b1 = sA[3], a0 = sB[0], a1 = sB[1];
                const LAS f32x4* kp = (const LAS f32x4*)(Ks + s * 144 + kq * 36); const LAS f32x4* qp = (const LAS f32x4*)(Qs + s * 144 + kq * 36);
                f32x4 k4[8];
                float ks0 = 0.f, ks1 = 0.f;
#pragma unroll
                for (int i4 = 0; i4 < 8; ++i4) { k4[i4] = kp[i4];
#pragma unroll
                    for (int j = 0; j < 4; ++j) { ks0 = fmaf(k4[i4][j], S0[4 * i4 + j], ks0); ks1 = fmaf(k4[i4][j], S1[4 * i4 + j], ks1); } }
                ks0 = quad_sum(ks0) * rk; ks1 = quad_sum(ks1) * rk;
                const float vv0 = V0s[s * 128 + v], vv1 = V1s[s * 128 + v];
                const float u0 = rk * b0 * (vv0 - a0 * ks0), u1 = rk * b1 * (vv1 - a1 * ks1);
                float op0 = 0.f, op1 = 0.f;
#pragma unroll
                for (int i4 = 0; i4 < 8; ++i4) { const f32x4 q4 = qp[i4];
#pragma unroll
                    for (int j = 0; j < 4; ++j) { const int i = 4 * i4 + j;
                        S0[i] = fmaf(k4[i4][j], u0, a0 * S0[i]); op0 = fmaf(q4[j], S0[i], op0);
                        S1[i] = fmaf(k4[i4][j], u1, a1 * S1[i]); op1 = fmaf(q4[j], S1[i], op1); } }
                op0 = quad_sum(op0) * rq; op1 = quad_sum(op1) * rq;
                if (kq == 0) { O0s[s * 128 + v] = op0; O1s[s * 128 + v] = op1; }
            }
            __syncthreads();
            {
                const LAS float* Oh = hh ? O1s : O0s;
                const f32x4 oa = *(const LAS f32x4*)(Oh + st * 128 + v0i), ob = *(const LAS f32x4*)(Oh + st * 128 + v0i + 4);
                float ss = ((oa[0] * oa[0] + oa[1] * oa[1]) + (oa[2] * oa[2] + oa[3] * oa[3])) + ((ob[0] * ob[0] + ob[1] * ob[1]) + (ob[2] * ob[2] + ob[3] * ob[3]));
#pragma unroll
                for (int m = 1; m < 16; m <<= 1) ss += __shfl_xor(ss, m);
                const float r = rsqrtf(ss * (1.0f / 128.0f) + EPS);
                v4u w;
                w.x = pk2(oa[0] * r * nw0[0] * bflo(zz.x), oa[1] * r * nw0[1] * bfhi(zz.x)); w.y = pk2(oa[2] * r * nw0[2] * bflo(zz.y), oa[3] * r * nw0[3] * bfhi(zz.y));
                w.z = pk2(ob[0] * r * nw1[0] * bflo(zz.z), ob[1] * r * nw1[1] * bfhi(zz.z)); w.w = pk2(ob[2] * r * nw1[2] * bflo(zz.w), ob[3] * r * nw1[3] * bfhi(zz.w));
                *(v4u*)(O + (size_t)(b * SEQ + c * 16 + st) * GDN_VAL + (2 * kh + hh) * 128 + v0i) = w;
            }
        }
    }
}

struct Args { const float* in[17]; float* out; unsigned char* ws; int ph_lo, ph_hi; };
#define CW_BAR 4096
__global__ void __launch_bounds__(NWAVES * 64, 2) trunk_fwd(Args args) {
    extern __shared__ __attribute__((aligned(16))) unsigned char lds[];
    Frame F;
    F.lds = (LAS unsigned char*)lds;
    F.MISC = (volatile LAS unsigned*)(F.lds + MISC_OFF);
    F.tid = threadIdx.x; F.lane = F.tid & 63; F.wave = __builtin_amdgcn_readfirstlane(F.tid >> 6);
    F.G = gridDim.x;
    unsigned char* ws = args.ws; F.ws = ws;
    F.ctl = (gu32*)(ws + WS_CTL);
    F.x = args.in[0]; F.c = args.in[1]; F.ada_w = args.in[2]; F.ada_b = args.in[3]; F.norm_w = args.in[4]; F.hg_w_in = args.in[5]; F.hg_lb = args.in[6]; F.hg_norm_w = args.in[7]; F.hg_w_out = args.in[8];
    F.gdn_w_in = args.in[9]; F.gdn_conv_w = args.in[10]; F.gdn_A_log = args.in[11]; F.gdn_dt_bias = args.in[12]; F.gdn_norm_w = args.in[13]; F.gdn_w_out = args.in[14]; F.ffn_gu = args.in[15]; F.ffn_down = args.in[16];
    F.out = args.out;
    for (int u = F.tid; u < (LDS_BYTES - LDSCTL_OFF) / 4; u += NWAVES * 64) ((LAS unsigned*)(F.lds + LDSCTL_OFF))[u] = 0u;
    __syncthreads();
    XcdBarrier bar; bar.bar = (unsigned*)(F.ctl + CW_BAR); bar.x = 0; bar.st = nullptr;
    if (MK_N_LAUNCHES == 1) bar = xcd_barrier_post((unsigned*)(F.ctl + CW_BAR), F.MISC + 8);
    const int lo = args.ph_lo, hi = args.ph_hi;
#define IN(k) (lo <= (k) && (k) < hi)
#define SEAM(k) do { if (MK_N_LAUNCHES == 1 && (k) + 1 < hi) xcd_barrier(bar); } while (0)
    bf16* const HO = (bf16*)(ws + WS_HO); bf16* const PB = (bf16*)(ws + WS_P); bf16* const YB = (bf16*)(ws + WS_Y); float* const BG = (float*)(ws + WS_BG);

    #ifndef NO_P0
    if (IN(0)) { p0_prologue(F); SEAM(0); }
#endif
    if (IN(1)) { row_pass(F, F.x, nullptr, nullptr, HO, 0, 0, 0, 0, 1, 0, 0); SEAM(1); }
    for (int s = 0; s < 8; ++s) {
        const int l = s >> 1, ffn = s & 1, gdn = l & 1, j = l >> 1, pb = 2 + 4 * s;
        { int tl = threadIdx.x; asm volatile("" : "+v"(tl)); F.tid = tl; F.lane = tl & 63; F.wave = __builtin_amdgcn_readfirstlane(tl >> 6); }
        if (IN(pb)) {
            if (ffn) {
                pg8::Gemm g{HO, (const bf16*)(ws + W_GU + (size_t)l * W_GU_SZ), MTOK, GU, DM}; pg8::StaticOrder S; S.init(MTOK, GU, F.G, (int)blockIdx.x);
                pg8::EpiSwiGLU E{PB, FFH};
                pg8::gemm_phase<pg8::EpiSwiGLU, pg8::StaticOrder, PG8_ALIGN, PG8_SP2>(F.lds, g, S, E);
            } else if (!gdn) {
                pg8::Gemm g{HO, (const bf16*)(ws + W_HGIN + (size_t)j * W_HGIN_SZ), MTOK, HG_IN, DM}; pg8::StaticOrder S; S.init(MTOK, HG_IN, F.G, (int)blockIdx.x);
                pg8::EpiHgProj E{PB, HG_IN, (const float*)(ws + WS_LB) + j * 2048};
                pg8::gemm_phase<pg8::EpiHgProj, pg8::StaticOrder, PG8_ALIGN, PG8_SP2>(F.lds, g, S, E);
            } else {
                const bf16* wt = (const bf16*)(ws + W_GDNIN + (size_t)j * W_GDNIN_SZ);
                pg8::Gemm g{HO, wt, MTOK, GDN_MAIN, DM}; pg8::StaticOrder S; S.init(MTOK, GDN_MAIN, F.G, (int)blockIdx.x);
                pg8::EpiGdnProj E{PB, GDN_MAIN};
                pg8::gemm_phase<pg8::EpiGdnProj, pg8::StaticOrder, PG8_ALIGN, PG8_SP2>(F.lds, g, S, E);
                gdn_tail(F, HO, wt + (size_t)GDN_MAIN * DM, F.gdn_A_log + j * 32, F.gdn_dt_bias + j * 32, BG);
            }
            SEAM(pb);
        }
        if (IN(pb + 1) && !ffn) {
#ifndef NO_HG
            if (!gdn) hgrn_scan(F, PB, HO, F.hg_norm_w + j * 128);
#endif
#ifndef NO_GDN
            if (gdn) gdn_scan(F, PB, BG, HO, F.gdn_conv_w + (size_t)j * 4 * 8192, F.gdn_norm_w + j * 128);
#endif
            SEAM(pb + 1);
        }
        if (IN(pb + 2)) {
            const bf16* A = ffn ? PB : HO;
            const bf16* Bt = ffn ? (const bf16*)(ws + W_DOWN + (size_t)l * W_DOWN_SZ) : (gdn ? (const bf16*)(ws + W_GDNOUT + (size_t)j * W_GDNOUT_SZ) : (const bf16*)(ws + W_HGOUT + (size_t)j * W_HGOUT_SZ));
            const int K = ffn ? FFH : (gdn ? GDN_VAL : DM);
            pg8::Gemm g{A, Bt, MTOK, DM, K}; pg8::StaticOrder S; S.init(MTOK, DM, F.G, (int)blockIdx.x);
            pg8::EpiPlain E{YB, DM};
            pg8::gemm_phase<pg8::EpiPlain, pg8::StaticOrder, PG8_ALIGN, PG8_SP2>(F.lds, g, S, E);
            SEAM(pb + 2);
        }
        if (IN(pb + 3)) {
            const float* xin = (s == 0) ? F.x : F.out;
            if (!ffn) row_pass(F, xin, YB, F.out, HO, l, 2, 1, l, 4, 3, 2);
            else row_pass(F, xin, YB, F.out, (s == 7) ? (bf16*)nullptr : HO, l, 5, 3, (s == 7) ? 0 : l + 1, 1, 0, 0);
            SEAM(pb + 3);
        }
    }
#undef IN
#undef SEAM
}

extern "C" void kernel_launch(void* const* d_in, const int* in_sizes, int n_in, void* d_out, int out_size, void* d_ws, size_t ws_size, hipStream_t stream) {
    static int grid = 0;
    if (grid == 0) {
        if (n_in != 17 || in_sizes[0] != MTOK * DM || out_size != MTOK * DM || ws_size < WS_END) { fprintf(stderr, "kernel_launch: unexpected shapes (n_in %d, in0 %d, out %d, ws %zu < %zu); nothing launched\n", n_in, n_in > 0 ? in_sizes[0] : -1, out_size, ws_size, (size_t)WS_END); grid = -1; return; }
        int dev = 0, cus = 0, per_cu = 0;
        if (hipGetDevice(&dev) != hipSuccess || hipDeviceGetAttribute(&cus, hipDeviceAttributeMultiprocessorCount, dev) != hipSuccess) { fprintf(stderr, "kernel_launch: device query failed\n"); grid = -1; return; }
        if (hipFuncSetAttribute((const void*)trunk_fwd, hipFuncAttributeMaxDynamicSharedMemorySize, LDS_BYTES) != hipSuccess) { fprintf(stderr, "kernel_launch: hipFuncSetAttribute failed\n"); grid = -1; return; }
        if (hipOccupancyMaxActiveBlocksPerMultiprocessor(&per_cu, (const void*)trunk_fwd, NWAVES * 64, LDS_BYTES) != hipSuccess || per_cu < 1) fprintf(stderr, "kernel_launch: note: occupancy query reports %d workgroups per CU\n", per_cu);
        (void)hipGetLastError();
        grid = cus;
    }
    if (grid < 0) return;
    if (hipMemsetAsync((char*)d_ws + WS_CTL, 0, CTL_ZERO_BYTES, stream) != hipSuccess) { fprintf(stderr, "kernel_launch: hipMemsetAsync failed\n"); return; }
    Args a{};
    for (int i = 0; i < 17; ++i) a.in[i] = (const float*)d_in[i];
    a.out = (float*)d_out; a.ws = (unsigned char*)d_ws;
    if (MK_N_LAUNCHES == 1) {
        a.ph_lo = 0; a.ph_hi = N_PHASES;
        hipLaunchKernelGGL(trunk_fwd, dim3(grid), dim3(NWAVES * 64), LDS_BYTES, stream, a);
    } else {
        for (int p = 0; p < N_PHASES; ++p) {
            if (p >= 2 && ((p - 2) & 3) == 1 && (((p - 2) >> 2) & 1)) continue;
            a.ph_lo = p; a.ph_hi = p + 1;
            hipLaunchKernelGGL(trunk_fwd, dim3(grid), dim3(NWAVES * 64), LDS_BYTES, stream, a);
        }
    }
    const hipError_t le = hipPeekAtLastError();
    if (le != hipSuccess) fprintf(stderr, "kernel_launch: launch failed: %s\n", hipGetErrorName(le));
}
```

```cpp
#include <hip/hip_runtime.h>
#include <cstdio>
#include <cstdint>
namespace pg8 {
#define PG8_LAS __attribute__((address_space(3)))
typedef unsigned short bf16_t;
typedef short bf16x8 __attribute__((ext_vector_type(8)));
typedef float f32x4 __attribute__((ext_vector_type(4)));
typedef unsigned u32x4 __attribute__((ext_vector_type(4)));
constexpr int BM = 256, BK = 64, HALF = 128, HTB = HALF * BK * 2  , STAGE_BYTES = 8 * HTB, NXCD = 8, WGM = 8;

__host__ __device__ __forceinline__ int lds_byte(int r, int c) { const int st = (r >> 4) * 2 + (c >> 5), rr = r & 15, cc = c & 31, ob = rr * 64 + cc * 2; return st * 1024 + (ob ^ (((ob >> 9) & 1) << 5)); }
__host__ __device__ __forceinline__ void stage_rc(int b, int& R, int& C) { const int st = b / 1024, sb = b % 1024, swz = sb ^ (((sb >> 9) & 1) << 5); R = (st >> 1) * 16 + swz / 64; C = (st & 1) * 32 + (swz % 64) / 2; }
__host__ __device__ __forceinline__ int perm32(int rho) { const int n = rho >> 4, i = rho & 15; return 8 * (i >> 2) + 4 * n + (i & 3); }

struct Unit { int pm, pn; };
struct Gemm { const bf16_t* A; const bf16_t* Bt; int M, N, K; };

struct StaticOrder {
    int nM, nN, nwg, G, c;
    __host__ __device__ void init(int M, int N, int G_, int c_) { nM = M / BM; nN = N / BM; nwg = nM * nN; G = G_; c = c_; }
    __host__ __device__ bool next(int i, Unit& u) const {
        const long L = (long)i * G + c; if (L >= nwg) return false;
        int wgid = (int)L; { const int q = nwg / NXCD, r = nwg % NXCD, xcd = wgid % NXCD, off = wgid / NXCD; wgid = (xcd < r ? xcd * (q + 1) : r * (q + 1) + (xcd - r) * q) + off; }
        const int nig = WGM * nN, gid = wgid / nig, fm = gid * WGM, gsz = (nM - fm) < WGM ? (nM - fm) : WGM;
        u.pm = fm + ((wgid % nig) % gsz); u.pn = (wgid % nig) / gsz;
#ifndef PG8_CG_ROT
#define PG8_CG_ROT 2
#endif
        if (PG8_CG_ROT > 1 && gsz == WGM) { const int ncg = nN / 4, cg = u.pn >> 2, blk = cg / PG8_CG_ROT, nfull = ncg / PG8_CG_ROT;
            if (blk < nfull) { const int xcd = (int)(L % NXCD); u.pn = ((blk * PG8_CG_ROT + (cg - blk * PG8_CG_ROT + xcd) % PG8_CG_ROT) << 2) | (u.pn & 3); } }
        return true;
    }
    __device__ __forceinline__ void a_ready(const Unit&) const {}
    __device__ __forceinline__ void done(const Unit&) const {}
};
__device__ __forceinline__ unsigned cvt_pk_bf16(float lo, float hi) { unsigned r; asm volatile("v_cvt_pk_bf16_f32 %0, %1, %2" : "=v"(r) : "v"(lo), "v"(hi)); return r; }
__device__ __forceinline__ float sigmoid_f(float x) { return __builtin_amdgcn_rcpf(1.0f + __expf(-x)); }
__device__ __forceinline__ float silu_f(float x) { return x * sigmoid_f(x); }
__device__ __forceinline__ u32x4 pack8(const f32x4 a, const f32x4 b) { u32x4 w; w.x = cvt_pk_bf16(a[0], a[1]); w.y = cvt_pk_bf16(a[2], a[3]); w.z = cvt_pk_bf16(b[0], b[1]); w.w = cvt_pk_bf16(b[2], b[3]); return w; }

struct EpiPlain {
    static constexpr bool PERM = true, AFTER_DRAIN = false;
    bf16_t* O; int ldc;
    __device__ __forceinline__ void operator()(const f32x4 (&acc)[2][2][4][2], const Unit& u, int wr, int wc, int fr, int fq) const {
        const int row0 = u.pm * BM + wr * 64 + fr, col0 = u.pn * BM + wc * 32 + 8 * fq;
#pragma unroll
        for (int ai = 0; ai < 2; ++ai)
#pragma unroll
            for (int m = 0; m < 4; ++m) { bf16_t* rowp = O + (size_t)(row0 + ai * HALF + m * 16) * ldc + col0;
#pragma unroll
                for (int bj = 0; bj < 2; ++bj) *(u32x4*)(rowp + bj * HALF) = pack8(acc[ai][bj][m][0], acc[ai][bj][m][1]); }
    }
};
struct EpiSwiGLU {
    static constexpr bool PERM = true, AFTER_DRAIN = false;
    bf16_t* O; int ldc;
    __device__ __forceinline__ void operator()(const f32x4 (&acc)[2][2][4][2], const Unit& u, int wr, int wc, int fr, int fq) const {
        const int row0 = u.pm * BM + wr * 64 + fr, col0 = u.pn * HALF + wc * 32 + 8 * fq;
#pragma unroll
        for (int ai = 0; ai < 2; ++ai)
#pragma unroll
            for (int m = 0; m < 4; ++m) { bf16_t* rowp = O + (size_t)(row0 + ai * HALF + m * 16) * ldc + col0;
                f32x4 h0, h1;
#pragma unroll
                for (int j = 0; j < 4; ++j) { h0[j] = silu_f(acc[ai][0][m][0][j]) * acc[ai][1][m][0][j]; h1[j] = silu_f(acc[ai][0][m][1][j]) * acc[ai][1][m][1][j]; }
                *(u32x4*)rowp = pack8(h0, h1); }
    }
};
struct EpiHgProj {
    static constexpr bool PERM = true, AFTER_DRAIN = false;
    bf16_t* O; int ldc; const float* lb;
    __device__ __forceinline__ void operator()(const f32x4 (&acc)[2][2][4][2], const Unit& u, int wr, int wc, int fr, int fq) const {
        const int row0 = u.pm * BM + wr * 64 + fr, col0 = u.pn * BM + wc * 32 + 8 * fq, seg = u.pn >> 3;
        f32x4 lbv[2][2];
#pragma unroll
        for (int bj = 0; bj < 2; ++bj)
#pragma unroll
            for (int n = 0; n < 2; ++n) lbv[bj][n] = (seg == 1) ? *(const f32x4*)(lb + (col0 - 2048) + bj * HALF + 4 * n) : (f32x4){0.f, 0.f, 0.f, 0.f};
#pragma unroll
        for (int ai = 0; ai < 2; ++ai)
#pragma unroll
            for (int m = 0; m < 4; ++m) { bf16_t* rowp = O + (size_t)(row0 + ai * HALF + m * 16) * ldc + col0;
#pragma unroll
                for (int bj = 0; bj < 2; ++bj) { f32x4 v[2] = {acc[ai][bj][m][0], acc[ai][bj][m][1]};
                    if (seg == 0) {
#pragma unroll
                        for (int n = 0; n < 2; ++n)
#pragma unroll
                            for (int j = 0; j < 4; ++j) v[n][j] = silu_f(v[n][j]);
                    } else if (seg == 1) {
#pragma unroll
                        for (int n = 0; n < 2; ++n)
#pragma unroll
                            for (int j = 0; j < 4; ++j) { const float l = lbv[bj][n][j]; v[n][j] = __logf(l + (1.0f - l) * sigmoid_f(v[n][j])); }
                    } else if (seg == 3) {
#pragma unroll
                        for (int n = 0; n < 2; ++n)
#pragma unroll
                            for (int j = 0; j < 4; ++j) v[n][j] = sigmoid_f(v[n][j]);
                    }
                    *(u32x4*)(rowp + bj * HALF) = pack8(v[0], v[1]); } }
    }
};
struct EpiGdnProj {
    static constexpr bool PERM = true, AFTER_DRAIN = false;
    bf16_t* O; int ldc;
    __device__ __forceinline__ void operator()(const f32x4 (&acc)[2][2][4][2], const Unit& u, int wr, int wc, int fr, int fq) const {
        const int row0 = u.pm * BM + wr * 64 + fr, col0 = u.pn * BM + wc * 32 + 8 * fq; const bool isz = u.pn >= 32;
#pragma unroll
        for (int ai = 0; ai < 2; ++ai)
#pragma unroll
            for (int m = 0; m < 4; ++m) { bf16_t* rowp = O + (size_t)(row0 + ai * HALF + m * 16) * ldc + col0;
#pragma unroll
                for (int bj = 0; bj < 2; ++bj) { f32x4 v[2] = {acc[ai][bj][m][0], acc[ai][bj][m][1]};
                    if (isz) {
#pragma unroll
                        for (int n = 0; n < 2; ++n)
#pragma unroll
                            for (int j = 0; j < 4; ++j) v[n][j] = silu_f(v[n][j]);
                    }
                    *(u32x4*)(rowp + bj * HALF) = pack8(v[0], v[1]); } }
    }
};

template <class Epi, class Sched, bool ALIGN_EPI = false, bool SP2 = false>
__device__ __forceinline__ void gemm_phase(PG8_LAS unsigned char* lds, const Gemm g, const Sched& S, const Epi& E) {
    int tid_ = threadIdx.x; asm volatile("" : "+v"(tid_));
    const int tid = tid_, wid = __builtin_amdgcn_readfirstlane(tid >> 6), lane = tid & 63, wr = wid >> 2, wc = wid & 3, fr = lane & 15, fq = lane >> 4;
    const int K = g.K, nt = K / BK;
    unsigned voffA[2], voffB[2];
#pragma unroll
    for (int i = 0; i < 2; ++i) { int R, C; stage_rc(tid * 16 + i * 8192, R, C); const int Rb = Epi::PERM ? ((R & ~31) + perm32(R & 31)) : R;
        voffA[i] = (unsigned)(R * K + C) * 2u; voffB[i] = (unsigned)(Rb * K + C) * 2u; }
    const size_t kstep = (size_t)(BK * 2);
    const size_t hstep = (size_t)HALF * K * 2;
    const size_t tstep = 2 * hstep;
    const unsigned ldsw = (unsigned)wid * 1024u;
    const int aoff = lds_byte(wr * 64 + fr, fq * 8), boff = lds_byte(wc * 32 + fr, fq * 8);
#define PG8_SA(b, h) (((b) * 2 + (h)) * HTB)
#define PG8_SB(b, h) ((4 + (b) * 2 + (h)) * HTB)
#define PG8_STAGE(bufoff, gbase, voff) do { _Pragma("unroll") for (int _i = 0; _i < 2; ++_i) \
        __builtin_amdgcn_global_load_lds((const unsigned*)((const char*)(gbase) + (voff)[_i]), (PG8_LAS unsigned*)(lds + (bufoff) + ldsw + _i * 8192), 16, 0, 0); } while (0)
#define PG8_LDA(dst, b, h) do { _Pragma("unroll") for (int m = 0; m < 4; ++m) _Pragma("unroll") for (int k = 0; k < 2; ++k) dst[m][k] = *(const PG8_LAS bf16x8*)(lds + PG8_SA(b, h) + aoff + m * 2048 + k * 1024); } while (0)
#define PG8_LDB(dst, b, h) do { _Pragma("unroll") for (int n = 0; n < 2; ++n) _Pragma("unroll") for (int k = 0; k < 2; ++k) dst[n][k] = *(const PG8_LAS bf16x8*)(lds + PG8_SB(b, h) + boff + n * 2048 + k * 1024); } while (0)
#define PG8_MMA(ai, bj, At, Bt) do { __builtin_amdgcn_s_setprio(1); _Pragma("unroll") for (int m = 0; m < 4; ++m) _Pragma("unroll") for (int n = 0; n < 2; ++n) _Pragma("unroll") for (int k = 0; k < 2; ++k) \
        acc[ai][bj][m][n] = __builtin_amdgcn_mfma_f32_16x16x32_bf16(Bt[n][k], At[m][k], acc[ai][bj][m][n], 0, 0, 0); __builtin_amdgcn_s_setprio(0); } while (0)
#define PG8_WAIT_V(n) asm volatile("s_waitcnt vmcnt(" #n ")" ::: "memory")
#define PG8_WAIT_L(n) asm volatile("s_waitcnt lgkmcnt(" #n ")" ::: "memory")
#define PG8_BAR __builtin_amdgcn_s_barrier()
#define PG8_SCHED __builtin_amdgcn_sched_barrier(0)
    Unit cur, nxt; int ui = 0;
    if (!S.next(0, cur)) return;
    f32x4 acc[2][2][4][2];
#pragma unroll
    for (int a = 0; a < 2; ++a)
#pragma unroll
        for (int b = 0; b < 2; ++b)
#pragma unroll
            for (int m = 0; m < 4; ++m)
#pragma unroll
                for (int n = 0; n < 2; ++n) acc[a][b][m][n] = (f32x4){0.f, 0.f, 0.f, 0.f};
    bf16x8 At[4][2], B0[2][2], B1[2][2];
    const char* cA = (const char*)g.A + (size_t)cur.pm * tstep; const char* cB = (const char*)g.Bt + (size_t)cur.pn * tstep;
    S.a_ready(cur);
    if constexpr (SP2) {
        PG8_STAGE(PG8_SB(0, 0), cB, voffB); PG8_STAGE(PG8_SB(0, 1), cB + hstep, voffB); PG8_STAGE(PG8_SA(0, 0), cA, voffA); PG8_STAGE(PG8_SA(0, 1), cA + hstep, voffA);
        if (wr == 1) PG8_BAR;
        PG8_WAIT_V(2); PG8_BAR;
        PG8_STAGE(PG8_SB(1, 0), cB + kstep, voffB); PG8_STAGE(PG8_SA(1, 0), cA + kstep, voffA); PG8_STAGE(PG8_SB(1, 1), cB + hstep + kstep, voffB);
        PG8_WAIT_V(6); PG8_BAR;
    } else {
        PG8_STAGE(PG8_SB(0, 0), cB, voffB); PG8_STAGE(PG8_SA(0, 0), cA, voffA); PG8_STAGE(PG8_SB(0, 1), cB + hstep, voffB); PG8_STAGE(PG8_SA(0, 1), cA + hstep, voffA);
        if (wr == 1) PG8_BAR;
        PG8_WAIT_V(4); PG8_BAR;
        PG8_STAGE(PG8_SB(1, 0), cB + kstep, voffB); PG8_STAGE(PG8_SA(1, 0), cA + kstep, voffA); PG8_STAGE(PG8_SB(1, 1), cB + hstep + kstep, voffB);
        PG8_WAIT_V(6); PG8_BAR;
    }
    for (;;) {
        const bool has_next = S.next(ui + 1, nxt);
        const char* nA = has_next ? (const char*)g.A + (size_t)nxt.pm * tstep : cA; const char* nB = has_next ? (const char*)g.Bt + (size_t)nxt.pn * tstep : cB;
        for (int t = 0; t < nt; t += 2) {
            const bool last = (t == nt - 2);
            const char* a1 = cA + (size_t)(t + 1) * kstep;
            const char* a2 = last ? nA : cA + (size_t)(t + 2) * kstep; const char* b2 = last ? nB : cB + (size_t)(t + 2) * kstep;
            const char* a3 = a2 + kstep; const char* b3 = b2 + kstep;
            if (last && has_next) S.a_ready(nxt);
            if constexpr (SP2) {
            PG8_LDB(B0, 0, 0); PG8_LDB(B1, 0, 1); PG8_SCHED; PG8_LDA(At, 0, 0); PG8_STAGE(PG8_SA(1, 1), a1 + hstep, voffA);
            PG8_WAIT_V(8); PG8_WAIT_L(0); PG8_BAR; PG8_MMA(0, 0, At, B0); PG8_MMA(0, 1, At, B1); PG8_BAR; PG8_SCHED;
            PG8_LDA(At, 0, 1); PG8_STAGE(PG8_SB(0, 0), b2, voffB); PG8_STAGE(PG8_SB(0, 1), b2 + hstep, voffB); PG8_STAGE(PG8_SA(0, 0), a2, voffA);
            PG8_WAIT_V(8); PG8_WAIT_L(0); PG8_BAR; PG8_MMA(1, 0, At, B0); PG8_MMA(1, 1, At, B1); PG8_BAR; PG8_SCHED;
            PG8_LDB(B0, 1, 0); PG8_LDB(B1, 1, 1); PG8_SCHED; PG8_LDA(At, 1, 0); PG8_STAGE(PG8_SA(0, 1), a2 + hstep, voffA);
            PG8_WAIT_V(8); PG8_WAIT_L(0); PG8_BAR; PG8_MMA(0, 0, At, B0); PG8_MMA(0, 1, At, B1); PG8_BAR; PG8_SCHED;
            PG8_LDA(At, 1, 1); PG8_STAGE(PG8_SB(1, 0), b3, voffB); PG8_STAGE(PG8_SB(1, 1), b3 + hstep, voffB); PG8_STAGE(PG8_SA(1, 0), a3, voffA);
            PG8_WAIT_V(8); PG8_WAIT_L(0); PG8_BAR; PG8_MMA(1, 0, At, B0); PG8_MMA(1, 1, At, B1); PG8_BAR; PG8_SCHED;
            } else {
            PG8_LDB(B0, 0, 0); PG8_SCHED; PG8_LDA(At, 0, 0); PG8_STAGE(PG8_SA(1, 1), a1 + hstep, voffA);
            PG8_WAIT_L(8); PG8_BAR; PG8_WAIT_L(0); PG8_MMA(0, 0, At, B0); PG8_BAR; PG8_SCHED;
            PG8_LDB(B1, 0, 1); PG8_STAGE(PG8_SB(0, 0), b2, voffB);
            PG8_BAR; PG8_WAIT_L(0); PG8_MMA(0, 1, At, B1); PG8_BAR;
            PG8_LDA(At, 0, 1); PG8_STAGE(PG8_SA(0, 0), a2, voffA);
            PG8_BAR; PG8_WAIT_L(0); PG8_MMA(1, 0, At, B0); PG8_BAR; PG8_SCHED;
            PG8_STAGE(PG8_SB(0, 1), b2 + hstep, voffB);
            PG8_WAIT_V(6); PG8_BAR; PG8_MMA(1, 1, At, B1); PG8_BAR;
            PG8_LDB(B0, 1, 0); PG8_SCHED; PG8_LDA(At, 1, 0); PG8_STAGE(PG8_SA(0, 1), a2 + hstep, voffA);
            PG8_WAIT_L(8); PG8_BAR; PG8_WAIT_L(0); PG8_MMA(0, 0, At, B0); PG8_BAR; PG8_SCHED;
            PG8_LDB(B1, 1, 1); PG8_STAGE(PG8_SB(1, 0), b3, voffB);
            PG8_BAR; PG8_WAIT_L(0); PG8_MMA(0, 1, At, B1); PG8_BAR;
            PG8_LDA(At, 1, 1); PG8_STAGE(PG8_SA(1, 0), a3, voffA);
            PG8_BAR; PG8_WAIT_L(0); PG8_MMA(1, 0, At, B0); PG8_BAR; PG8_SCHED;
            PG8_STAGE(PG8_SB(1, 1), b3 + hstep, voffB);
            PG8_WAIT_V(6); PG8_BAR; PG8_MMA(1, 1, At, B1); PG8_BAR;
            }
        }
        if constexpr (ALIGN_EPI) { if (wr == 0) PG8_BAR; }
        if constexpr (!Epi::AFTER_DRAIN) { E(acc, cur, wr, wc, fr, fq); S.done(cur); }
        if (!has_next) break;
#pragma unroll
        for (int a = 0; a < 2; ++a)
#pragma unroll
            for (int b = 0; b < 2; ++b)
#pragma unroll
                for (int m = 0; m < 4; ++m)
#pragma unroll
                    for (int n = 0; n < 2; ++n) acc[a][b][m][n] = (f32x4){0.f, 0.f, 0.f, 0.f};
        cur = nxt; cA = nA; cB = nB; ++ui;
        if constexpr (ALIGN_EPI) { if (wr == 1) PG8_BAR; }
    }
    PG8_WAIT_V(0);
    if constexpr (!ALIGN_EPI) { if (wr == 0) PG8_BAR; }
    PG8_BAR;
    if constexpr (Epi::AFTER_DRAIN) { E.fused(acc, cur, wr, wc, fr, fq, lds, wid, lane); S.done(cur); }
#undef PG8_SA
#undef PG8_SB
#undef PG8_STAGE
#undef PG8_LDA
#undef PG8_LDB
#undef PG8_MMA
#undef PG8_WAIT_V
#undef PG8_WAIT_L
#undef PG8_BAR
#undef PG8_SCHED
}
}
#ifndef PG8_SP2
#define PG8_SP2 true
#endif
#ifndef PG8_ALIGN
#define PG8_ALIGN true
#endif
#ifndef MK_N_LAUNCHES
#define MK_N_LAUNCHES 1
#endif

constexpr int NWAVES = 8;
constexpr int DM = 2048, NBATCH = 16, SEQ = 2048, MTOK = NBATCH * SEQ, DEPTH = 4;
constexpr int HG_IN = 8192, GDN_IN = 12352, GDN_MAIN = 12288, FFH = 5632, GU = 2 * FFH, NMOD = 6 * DM, GDN_VAL = 4096;
constexpr float EPS = 1e-6f;
constexpr int N_PHASES = 2 + 4 * 8;

constexpr size_t MiB = 1u << 20;
constexpr size_t WS_CTL = 0, CTL_ZERO_BYTES = 1 * MiB;
constexpr size_t WS_MODP = 1 * MiB;
constexpr size_t WS_LB = 13 * MiB;
constexpr size_t WS_BG = 14 * MiB;
constexpr size_t WS_W = 24 * MiB;
constexpr size_t W_HGIN = WS_W, W_HGIN_SZ = (size_t)HG_IN * DM * 2;
constexpr size_t W_HGOUT = W_HGIN + 2 * W_HGIN_SZ, W_HGOUT_SZ = (size_t)DM * DM * 2;
constexpr size_t W_GDNIN = W_HGOUT + 2 * W_HGOUT_SZ, W_GDNIN_SZ = (size_t)GDN_IN * DM * 2;
constexpr size_t W_GDNOUT = W_GDNIN + 2 * W_GDNIN_SZ, W_GDNOUT_SZ = (size_t)DM * GDN_VAL * 2;
constexpr size_t W_GU = W_GDNOUT + 2 * W_GDNOUT_SZ, W_GU_SZ = (size_t)GU * DM * 2;
constexpr size_t W_DOWN = W_GU + 4 * W_GU_SZ, W_DOWN_SZ = (size_t)DM * FFH * 2;
constexpr size_t W_END = W_DOWN + 4 * W_DOWN_SZ;
constexpr size_t WS_HO = 500 * MiB;
constexpr size_t WS_P = 756 * MiB;
constexpr size_t WS_Y = WS_P + 512 * MiB;
constexpr size_t WS_END = WS_P + 768 * MiB;
static_assert(W_END <= WS_HO, "weights overflow");
static_assert((size_t)MTOK * FFH * 2 <= 512 * MiB, "hidden must not reach y");

constexpr int RING_BYTES = 131072;
constexpr int LDSCTL_OFF = RING_BYTES, MISC_OFF = LDSCTL_OFF + 320;
constexpr int LDS_BYTES = 147456;

#define GAS __attribute__((address_space(1)))
#define LAS __attribute__((address_space(3)))
typedef unsigned short bf16;
typedef unsigned v4u __attribute__((ext_vector_type(4)));
typedef unsigned v2u __attribute__((ext_vector_type(2)));
typedef float f32x4 __attribute__((ext_vector_type(4)));
typedef short bf16x8 __attribute__((ext_vector_type(8)));
typedef GAS unsigned gu32;
#define RLX_AGENT __ATOMIC_RELAXED, __HIP_MEMORY_SCOPE_AGENT
#define LDS_WAIT() asm volatile("s_waitcnt lgkmcnt(0)" ::: "memory")
#define VM_WAIT() asm volatile("s_waitcnt vmcnt(0)" ::: "memory")
typedef float f32x2_t __attribute__((ext_vector_type(2))); typedef __bf16 bf16x2_t __attribute__((ext_vector_type(2)));
__device__ __forceinline__ unsigned cvtpk_s(float lo, float hi) { f32x2_t v = {lo, hi}; bf16x2_t b = __builtin_convertvector(v, bf16x2_t); return __builtin_bit_cast(unsigned, b); }
__device__ __forceinline__ unsigned pk2(float lo, float hi) { return cvtpk_s(lo, hi); }
__device__ __forceinline__ unsigned f2bf(float f) { return cvtpk_s(f, 0.f) & 0xffffu; }
__device__ __forceinline__ float bflo(unsigned w) { return __builtin_bit_cast(float, w << 16); }
__device__ __forceinline__ float bfhi(unsigned w) { return __builtin_bit_cast(float, w & 0xffff0000u); }
__device__ __forceinline__ float bf1(unsigned short h) { return __builtin_bit_cast(float, ((unsigned)h) << 16); }
template <int CTRL> __device__ __forceinline__ float dpp0(float x) {
    return __builtin_bit_cast(float, __builtin_amdgcn_update_dpp(0, __builtin_bit_cast(int, x), CTRL, 0xf, 0xf, true)); }
__device__ __forceinline__ float row16_sum(float x) {
    x += dpp0<0x128>(x); x += dpp0<0x124>(x); x += dpp0<0x122>(x); x += dpp0<0x121>(x); return x; }
__device__ __forceinline__ float oct_sum(float x) {
    x += dpp0<0x141>(x); x += dpp0<0xB1>(x); x += dpp0<0x4E>(x); return x; }
__device__ __forceinline__ float quad_tot(float x) { x += dpp0<0xB1>(x); x += dpp0<0x4E>(x); return x; }
__device__ __forceinline__ float wave_sum(float v) {
    v = row16_sum(v);
    const int vi = __builtin_bit_cast(int, v);
    return (__builtin_bit_cast(float, __builtin_amdgcn_readlane(vi, 0)) + __builtin_bit_cast(float, __builtin_amdgcn_readlane(vi, 16))) + (__builtin_bit_cast(float, __builtin_amdgcn_readlane(vi, 32)) + __builtin_bit_cast(float, __builtin_amdgcn_readlane(vi, 48)));
}
__device__ __forceinline__ float quad_sum(float x) {
    int xi = __builtin_bit_cast(int, x);
    x += __builtin_bit_cast(float, __builtin_amdgcn_update_dpp(xi, xi, 0xB1, 0xf, 0xf, false));
    xi = __builtin_bit_cast(int, x);
    x += __builtin_bit_cast(float, __builtin_amdgcn_update_dpp(xi, xi, 0x4E, 0xf, 0xf, false));
    return x;
}
__device__ __forceinline__ float sigm(float x) { return __builtin_amdgcn_rcpf(1.0f + __expf(-x)); }

#define XB_TMO      128
#define XB_XCNT(j)  (256  + 64 * (j))
#define XB_XSUB(j)  (1280 + 64 * (j))
#define XB_XGEN(j)  (2304 + 64 * (j))
#define XB_TOP      3328
#define XB_TOPGEN   3392
#define XCD_BAR_WORDS 3456
#define XB_SPIN_CAP (1u << 18)

__device__ __forceinline__ unsigned xb_ld(unsigned* p)              { return __hip_atomic_load(p, __ATOMIC_RELAXED, __HIP_MEMORY_SCOPE_AGENT); }
__device__ __forceinline__ unsigned xb_add(unsigned* p, unsigned v) { return __hip_atomic_fetch_add(p, v, __ATOMIC_RELAXED, __HIP_MEMORY_SCOPE_AGENT); }
__device__ __forceinline__ unsigned xb_xcc_id() { return (unsigned)__builtin_amdgcn_s_getreg((3 << 11) | 20) & 0xFu; }
#define XB_SPIN(cond, bar) do { unsigned _sp = 0; while (cond) { __builtin_amdgcn_s_sleep(1); \
    if ((++_sp & 255u) == 0u) { if (xb_ld(&(bar)[XB_TMO])) break; if (_sp > XB_SPIN_CAP) { atomicAdd(&(bar)[XB_TMO], 1u); break; } } } } while (0)

struct XcdBarrier {
    unsigned* bar; unsigned x;
    volatile LAS unsigned* st;
};

__device__ __forceinline__ XcdBarrier xcd_barrier_post(unsigned* bar, volatile LAS unsigned* st) {
    XcdBarrier b; b.bar = bar; b.x = xb_xcc_id(); b.st = st;
    if (threadIdx.x == 0) (void)xb_add(&bar[XB_XCNT(b.x)], 1u);
    return b;
}
__device__ __forceinline__ void xcd_barrier_complete(unsigned* bar, unsigned x, unsigned& nloc, unsigned& nx) {
    const unsigned G = gridDim.x * gridDim.y * gridDim.z;
    unsigned sum, cnt, mine, sp = 0u;
    for (;;) {
        sum = 0u; cnt = 0u; mine = 0u;
#pragma unroll
        for (unsigned j = 0; j < 16; ++j) { const unsigned c = xb_ld(&bar[XB_XCNT(j)]); sum += c; cnt += (c > 0u) ? 1u : 0u; mine = (j == x) ? c : mine; }
        if (sum == G) break;
        __builtin_amdgcn_s_sleep(1);
        if ((++sp & 255u) == 0u) { if (xb_ld(&bar[XB_TMO])) break; if (sp > XB_SPIN_CAP) { atomicAdd(&bar[XB_TMO], 1u); break; } }
    }
    nloc = mine > 0u ? mine : 1u; nx = cnt > 0u ? cnt : 1u;
}

__device__ __forceinline__ void xcd_barrier(const XcdBarrier& b) {
    asm volatile("s_waitcnt vmcnt(0)" ::: "memory");
    __syncthreads();
    if (threadIdx.x == 0) {
        unsigned* bar = b.bar;
        __builtin_amdgcn_s_waitcnt(0);
        unsigned nloc = b.st[0], nx = b.st[1];
        if (nloc == 0u) { xcd_barrier_complete(bar, b.x, nloc, nx); b.st[0] = nloc; b.st[1] = nx; }
        const unsigned old = xb_add(&bar[XB_XSUB(b.x)], 1u);
        const unsigned gen = old / nloc;
        if (old + 1u == (gen + 1u) * nloc) {
            __builtin_amdgcn_fence(__ATOMIC_RELEASE, "agent");
            asm volatile("s_waitcnt vmcnt(0)" ::: "memory");
            const unsigned og = xb_add(&bar[XB_TOP], 1u);
            const unsigned tg = og / nx;
            if (og + 1u == (tg + 1u) * nx) xb_add(&bar[XB_TOPGEN], 1u);
            else XB_SPIN(xb_ld(&bar[XB_TOPGEN]) == tg, bar);
            __builtin_amdgcn_fence(__ATOMIC_ACQUIRE, "agent");
            xb_add(&bar[XB_XGEN(b.x)], 1u);
            asm volatile("s_waitcnt vmcnt(0)" ::: "memory");
        } else {
            XB_SPIN(xb_ld(&bar[XB_XGEN(b.x)]) == gen, bar);
            __builtin_amdgcn_fence(__ATOMIC_ACQUIRE, "agent");
            asm volatile("s_waitcnt vmcnt(0)" ::: "memory");
        }
    }
    __syncthreads();
}
struct Frame {
    LAS unsigned char* lds;
    volatile LAS unsigned* MISC;
    gu32* ctl;
    int tid, lane, wave, G;
    const float *x, *c, *ada_w, *ada_b, *norm_w, *hg_w_in, *hg_lb, *hg_norm_w, *hg_w_out, *gdn_w_in, *gdn_conv_w, *gdn_A_log, *gdn_dt_bias, *gdn_norm_w, *gdn_w_out, *ffn_gu, *ffn_down;
    float* out; unsigned char* ws;
};

__device__ __forceinline__ void p0_mod_task(Frame& F, int task) {
    const int cb = task % 192, kq = task / 192, l = cb / 48, n0 = (cb % 48) * 256;
    LAS float* CA = (LAS float*)F.lds;
    LAS float* RED = (LAS float*)(F.lds + 32768);
    float* modp = (float*)(F.ws + WS_MODP);
    {
        const int k = F.tid;
#pragma unroll
        for (int b = 0; b < 16; ++b) { const float cv = F.c[b * DM + kq * 512 + k]; CA[k * 16 + b] = cv * sigm(cv); }
    }
    __syncthreads();
    f32x4 acc[16];
#pragma unroll
    for (int b = 0; b < 16; ++b) acc[b] = (f32x4){0.f, 0.f, 0.f, 0.f};
    const float* wp = F.ada_w + ((size_t)l * DM + kq * 512 + F.wave * 64) * NMOD + n0 + 4 * F.lane;
#pragma unroll 4
    for (int kk = 0; kk < 64; ++kk) {
        const f32x4 wv = *(const f32x4*)(wp + (size_t)kk * NMOD);
        const LAS f32x4* cp = (const LAS f32x4*)(CA + (F.wave * 64 + kk) * 16);
        const f32x4 c0 = cp[0], c1 = cp[1], c2 = cp[2], c3 = cp[3];
#pragma unroll
        for (int j = 0; j < 4; ++j) { acc[j] += c0[j] * wv; acc[4 + j] += c1[j] * wv; acc[8 + j] += c2[j] * wv; acc[12 + j] += c3[j] * wv; }
    }
#pragma unroll
    for (int p = 0; p < 4; ++p) {
        __syncthreads();
        LAS f32x4* rp = (LAS f32x4*)(RED + (F.wave * 64 + F.lane) * 16);
        rp[0] = acc[4 * p]; rp[1] = acc[4 * p + 1]; rp[2] = acc[4 * p + 2]; rp[3] = acc[4 * p + 3];
        __syncthreads();
#pragma unroll
        for (int e = 0; e < 2; ++e) {
            const int o = F.tid + 512 * e, bi = o >> 8, nn = o & 255, ln = nn >> 2, ci = nn & 3;
            float s = 0.f;
#pragma unroll
            for (int w = 0; w < 8; ++w) s += RED[(w * 64 + ln) * 16 + bi * 4 + ci];
            modp[(((size_t)kq * 4 + l) * 16 + (4 * p + bi)) * NMOD + n0 + nn] = s;
        }
    }
    __syncthreads();
}
__device__ __forceinline__ void transpose_item(const float* W, int K, int N, bf16* WT, int rowb, int k0, int n0, LAS float* scr, int lane) {
#pragma unroll 8
    for (int i = 0; i < 32; ++i) { const int kk = 2 * i + (lane >> 5); scr[kk * 33 + (lane & 31)] = W[(size_t)(k0 + kk) * N + n0 + (lane & 31)]; }
    LDS_WAIT(); asm volatile("" ::: "memory");
    const int c = lane & 7;
#pragma unroll
    for (int j = 0; j < 4; ++j) { const int n = (lane >> 3) + 8 * j; const LAS float* s = scr + (8 * c) * 33 + n;
        v4u o; o.x = pk2(s[0 * 33], s[1 * 33]); o.y = pk2(s[2 * 33], s[3 * 33]); o.z = pk2(s[4 * 33], s[5 * 33]); o.w = pk2(s[6 * 33], s[7 * 33]);
        *(GAS v4u*)(WT + (size_t)(rowb + n) * K + k0 + 8 * c) = o; }
    LDS_WAIT(); asm volatile("" ::: "memory");
}
constexpr int I_HGIN = (DM / 64) * (HG_IN / 32), I_HGOUT = (DM / 64) * (DM / 32), I_GDNIN = (DM / 64) * (GDN_IN / 32), I_GDNOUT = (GDN_VAL / 64) * (DM / 32), I_GU = (DM / 64) * (GU / 32), I_DOWN = (FFH / 64) * (DM / 32);
constexpr int NITEMS = 2 * I_HGIN + 2 * I_HGOUT + 2 * I_GDNIN + 2 * I_GDNOUT + 4 * I_GU + 4 * I_DOWN;
__device__ __forceinline__ void p0_prologue(Frame& F) {
    for (int task = blockIdx.x; task < 768; task += F.G) p0_mod_task(F, task);
    if (blockIdx.x == 0) {
        float* lb = (float*)(F.ws + WS_LB);
        for (int n = F.tid; n < 2048; n += 512) { const float l0 = F.hg_lb[n], l1 = F.hg_lb[2048 + n]; lb[n] = 0.f; lb[2048 + n] = 1.0f / (1.0f + expf(l0 - l1)); }
    }
    LAS float* scr = (LAS float*)(F.lds + F.wave * 16384);
    const int gw = blockIdx.x * NWAVES + F.wave, NGW = F.G * NWAVES;
    for (int it = gw; it < NITEMS; it += NGW) {
        int r = it, K, N, mode = 0; const float* W; bf16* WT;
        if (r < 2 * I_HGIN) { const int j = r / I_HGIN; r -= j * I_HGIN; W = F.hg_w_in + (size_t)j * DM * HG_IN; WT = (bf16*)(F.ws + W_HGIN + j * W_HGIN_SZ); K = DM; N = HG_IN; }
        else if ((r -= 2 * I_HGIN) < 2 * I_HGOUT) { const int j = r / I_HGOUT; r -= j * I_HGOUT; W = F.hg_w_out + (size_t)j * DM * DM; WT = (bf16*)(F.ws + W_HGOUT + j * W_HGOUT_SZ); K = DM; N = DM; }
        else if ((r -= 2 * I_HGOUT) < 2 * I_GDNIN) { const int j = r / I_GDNIN; r -= j * I_GDNIN; W = F.gdn_w_in + (size_t)j * DM * GDN_IN; WT = (bf16*)(F.ws + W_GDNIN + j * W_GDNIN_SZ); K = DM; N = GDN_IN; }
        else if ((r -= 2 * I_GDNIN) < 2 * I_GDNOUT) { const int j = r / I_GDNOUT; r -= j * I_GDNOUT; W = F.gdn_w_out + (size_t)j * GDN_VAL * DM; WT = (bf16*)(F.ws + W_GDNOUT + j * W_GDNOUT_SZ); K = GDN_VAL; N = DM; }
        else if ((r -= 2 * I_GDNOUT) < 4 * I_GU) { const int j = r / I_GU; r -= j * I_GU; W = F.ffn_gu + (size_t)j * DM * GU; WT = (bf16*)(F.ws + W_GU + j * W_GU_SZ); K = DM; N = GU; mode = 1; }
        else { r -= 4 * I_GU; const int j = r / I_DOWN; r -= j * I_DOWN; W = F.ffn_down + (size_t)j * FFH * DM; WT = (bf16*)(F.ws + W_DOWN + j * W_DOWN_SZ); K = FFH; N = DM; }
        const int nblk = N / 32, kb = r / nblk, nb = r % nblk, k0 = 64 * kb, n0 = 32 * nb;
        int rowb = n0;
        if (mode == 1) rowb = (n0 < FFH) ? 256 * (n0 / 128) + (n0 % 128) : 256 * ((n0 - FFH) / 128) + 128 + ((n0 - FFH) % 128);
        transpose_item(W, K, N, WT, rowb, k0, n0, scr, F.lane);
    }
}

typedef _Float16 h16x4 __attribute__((ext_vector_type(4)));
__device__ __forceinline__ f32x4 modval(const float* modp, const float* ada_b, int l, int b, int off) {
    f32x4 s = *(const f32x4*)(ada_b + (size_t)l * NMOD + off);
#pragma unroll
    for (int kq = 0; kq < 4; ++kq) s += *(const f32x4*)(modp + (((size_t)kq * 4 + l) * 16 + b) * NMOD + off);
    return s;
}
__device__ __forceinline__ void row_pass(Frame& F, const float* xin32, const bf16* xin16, const bf16* y, float* xo32, bf16* xo16, bf16* hout, int lg, int gchunk, int wyi, int lh, int scchunk, int shchunk, int whi) {
    LAS float* GW = (LAS float*)F.lds; LAS float* WSv = GW + 2048; LAS float* SH = GW + 4096;
    const float* modp = (const float*)(F.ws + WS_MODP);
    for (int rb = blockIdx.x; rb < MTOK / 128; rb += F.G) {
        const int b = rb >> 4;
        __syncthreads();
        {
            const int n = 4 * F.tid;
            if (y) { const f32x4 g = modval(modp, F.ada_b, lg, b, gchunk * DM + n); const f32x4 w = *(const f32x4*)(F.norm_w + (size_t)(lg * 4 + wyi) * DM + n); *(LAS f32x4*)(GW + n) = g * w; }
            if (hout) { const f32x4 sc = modval(modp, F.ada_b, lh, b, scchunk * DM + n), sh = modval(modp, F.ada_b, lh, b, shchunk * DM + n); const f32x4 w = *(const f32x4*)(F.norm_w + (size_t)(lh * 4 + whi) * DM + n);
                *(LAS f32x4*)(WSv + n) = w * (sc + 1.0f); *(LAS f32x4*)(SH + n) = sh; }
        }
        __syncthreads();
        for (int i = 0; i < 16; ++i) {
            const size_t row = (size_t)rb * 128 + F.wave + 8 * i;
            f32x4 xv[8];
            if (xin32) {
                const f32x4* xr = (const f32x4*)(xin32 + row * DM) + F.lane;
#pragma unroll
                for (int j = 0; j < 8; ++j) xv[j] = xr[64 * j];
            } else {
                const h16x4* xr = (const h16x4*)(xin16 + row * DM) + F.lane;
#pragma unroll
                for (int j = 0; j < 8; ++j) xv[j] = __builtin_convertvector(xr[64 * j], f32x4);
            }
            if (y) {
                const v2u* yr = (const v2u*)(y + row * DM) + F.lane;
                f32x4 yv[8]; float ss = 0.f;
#pragma unroll
                for (int j = 0; j < 8; ++j) { const v2u w = yr[64 * j]; yv[j] = (f32x4){bflo(w.x), bfhi(w.x), bflo(w.y), bfhi(w.y)}; ss += (yv[j][0] * yv[j][0] + yv[j][1] * yv[j][1]) + (yv[j][2] * yv[j][2] + yv[j][3] * yv[j][3]); }
                const float ry = rsqrtf(wave_sum(ss) * (1.0f / DM) + EPS);
#pragma unroll
                for (int j = 0; j < 8; ++j) { const f32x4 g = *(const LAS f32x4*)(GW + 4 * F.lane + 256 * j); xv[j] += g * (yv[j] * ry); }
                if (xo32) {
                    f32x4* xo = (f32x4*)(xo32 + row * DM) + F.lane;
#pragma unroll
                    for (int j = 0; j < 8; ++j) xo[64 * j] = xv[j];
                } else {
                    h16x4* xo = (h16x4*)(xo16 + row * DM) + F.lane;
#pragma unroll
                    for (int j = 0; j < 8; ++j) xo[64 * j] = __builtin_convertvector(xv[j], h16x4);
                }
            }
            if (hout) {
                float ss = 0.f;
#pragma unroll
                for (int j = 0; j < 8; ++j) ss += (xv[j][0] * xv[j][0] + xv[j][1] * xv[j][1]) + (xv[j][2] * xv[j][2] + xv[j][3] * xv[j][3]);
                const float rx = rsqrtf(wave_sum(ss) * (1.0f / DM) + EPS);
                v2u* ho = (v2u*)(hout + row * DM) + F.lane;
#pragma unroll
                for (int j = 0; j < 8; ++j) { const f32x4 w = *(const LAS f32x4*)(WSv + 4 * F.lane + 256 * j), s = *(const LAS f32x4*)(SH + 4 * F.lane + 256 * j);
                    const f32x4 hv = xv[j] * rx * w + s; v2u o; o.x = pk2(hv[0], hv[1]); o.y = pk2(hv[2], hv[3]); ho[64 * j] = o; }
            }
        }
    }
}

__device__ __forceinline__ void gdn_tail(Frame& F, const bf16* H, const bf16* WT, const float* A_log, const float* dt_bias, float* BG) {
    const int gw = blockIdx.x * NWAVES + F.wave, NGW = F.G * NWAVES, r16 = F.lane & 15, g = F.lane >> 4;
    for (int tile = gw; tile < MTOK / 16; tile += NGW) {
        const int row0 = tile * 16;
        f32x4 acc[4];
#pragma unroll
        for (int nt = 0; nt < 4; ++nt) acc[nt] = (f32x4){0.f, 0.f, 0.f, 0.f};
        const bf16* ap = H + (size_t)(row0 + r16) * DM + 8 * g;
        const bf16* bp = WT + (size_t)r16 * DM + 8 * g;
#pragma unroll 4
        for (int kk = 0; kk < DM / 32; ++kk) {
            const bf16x8 a = *(const bf16x8*)(ap + 32 * kk);
#pragma unroll
            for (int nt = 0; nt < 4; ++nt) { const bf16x8 bb = *(const bf16x8*)(bp + (size_t)nt * 16 * DM + 32 * kk); acc[nt] = __builtin_amdgcn_mfma_f32_16x16x32_bf16(a, bb, acc[nt], 0, 0, 0); }
        }
#pragma unroll
        for (int nt = 0; nt < 4; ++nt)
#pragma unroll
            for (int r = 0; r < 4; ++r) {
                const int row = row0 + 4 * g + r, col = nt * 16 + r16; const float v = acc[nt][r]; float o;
                if (nt < 2) o = sigm(v);
                else { const int hd = col - 32; const float xx = v + dt_bias[hd]; const float sp = xx > 20.f ? xx : log1pf(expf(xx)); o = -expf(A_log[hd]) * sp; }
                BG[(size_t)row * 64 + col] = o;
            }
    }
}

__device__ __forceinline__ int kperm(int kk) { return 8 * ((kk & 15) >> 2) + 4 * (kk >> 4) + (kk & 3); }
__device__ __forceinline__ bf16x8 pack8v(const f32x4 a, const f32x4 b) { v4u w; w.x = cvtpk_s(a[0], a[1]); w.y = cvtpk_s(a[2], a[3]); w.z = cvtpk_s(b[0], b[1]); w.w = cvtpk_s(b[2], b[3]); return __builtin_bit_cast(bf16x8, w); }
__device__ __forceinline__ void hgrn_scan(Frame& F, const bf16* P, bf16* O, const float* normw) {
    LAS unsigned char* L = F.lds;
    constexpr int AL = 0, BL = 8704, KTL = 17408, VTL = 27648, DLo = 37888, DMo = 38400, OSo = 38912;
    const int t = F.tid, w = F.wave, c16 = F.lane & 15, g = F.lane >> 4;
    const int kp = t >> 3, to = t & 7, k0 = 2 * kp;
    const int et = t >> 4, ev8 = (t & 15) * 8;
    const int pk0 = (k0 & ~31) + kperm(k0 & 31);
    const int ps0 = 8 * (to & 3) + 4 * (to >> 2);
    for (int unit = blockIdx.x; unit < NBATCH * 16; unit += F.G) {
        const int b = unit >> 4, h = unit & 15;
        f32x4 Sacc[8];
#pragma unroll
        for (int i = 0; i < 8; ++i) Sacc[i] = (f32x4){0.f, 0.f, 0.f, 0.f};
        const bf16* pq = P + (size_t)(b * SEQ + 4 * to) * HG_IN + h * 128 + k0;
        const bf16* pg = P + (size_t)(b * SEQ + et) * HG_IN + 6144 + h * 128 + ev8;
        unsigned rq[4], rf[4], rv[4];
#pragma unroll
        for (int i = 0; i < 4; ++i) { rq[i] = *(const unsigned*)(pq + (size_t)i * HG_IN); rf[i] = *(const unsigned*)(pq + (size_t)i * HG_IN + 2048); rv[i] = *(const unsigned*)(pq + (size_t)i * HG_IN + 4096); }
        v4u rgate = *(const v4u*)pg;
        const f32x4 nw0 = *(const f32x4*)(normw + ev8), nw1 = *(const f32x4*)(normw + ev8 + 4);
        __syncthreads();
        for (int c = 0; c < SEQ / 32; ++c) {
            {
                float b0[4], b1[4], run0 = 0.f, run1 = 0.f;
#pragma unroll
                for (int i = 0; i < 4; ++i) { run0 += bflo(rf[i]); b0[i] = run0; run1 += bfhi(rf[i]); b1[i] = run1; }
                float s0 = run0, s1 = run1;
                { const float u0 = dpp0<0x111>(s0), u1 = dpp0<0x111>(s1); if (to >= 1) { s0 += u0; s1 += u1; } }
                { const float u0 = dpp0<0x112>(s0), u1 = dpp0<0x112>(s1); if (to >= 2) { s0 += u0; s1 += u1; } }
                { const float u0 = dpp0<0x114>(s0), u1 = dpp0<0x114>(s1); if (to >= 4) { s0 += u0; s1 += u1; } }
                const float off0 = s0 - run0, off1 = s1 - run1;
                const float bl0 = oct_sum(run0), bl1 = oct_sum(run1);
                const float q0 = quad_tot(run0), q1 = quad_tot(run1), q0s = dpp0<0x114>(q0), q1s = dpp0<0x114>(q1);
                const float bm0 = to < 4 ? q0 : q0s, bm1 = to < 4 ? q1 : q1s;
                float kt0[4], kt1[4];
#pragma unroll
                for (int i = 0; i < 4; ++i) {
                    const float bb0 = off0 + b0[i], bb1 = off1 + b1[i];
                    const float kk0 = 1.0f - __expf(bflo(rf[i])), kk1 = 1.0f - __expf(bfhi(rf[i]));
                    const float a0 = bflo(rq[i]) * __expf(bb0 - bm0), a1 = bfhi(rq[i]) * __expf(bb1 - bm1);
                    const float m0 = kk0 * __expf(bm0 - bb0), m1 = kk1 * __expf(bm1 - bb1);
                    kt0[i] = kk0 * __expf(bl0 - bb0); kt1[i] = kk1 * __expf(bl1 - bb1);
                    *(LAS unsigned*)(L + AL + (4 * to + i) * 272 + pk0 * 2) = pk2(a0, a1);
                    *(LAS unsigned*)(L + BL + (4 * to + i) * 272 + pk0 * 2) = pk2(m0, m1);
                }
                v2u x; x.x = pk2(kt0[0], kt0[1]); x.y = pk2(kt0[2], kt0[3]); *(LAS v2u*)(L + KTL + k0 * 80 + ps0 * 2) = x;
                x.x = pk2(kt1[0], kt1[1]); x.y = pk2(kt1[2], kt1[3]); *(LAS v2u*)(L + KTL + (k0 + 1) * 80 + ps0 * 2) = x;
                x.x = (rv[0] & 0xffffu) | (rv[1] << 16); x.y = (rv[2] & 0xffffu) | (rv[3] << 16); *(LAS v2u*)(L + VTL + k0 * 80 + ps0 * 2) = x;
                x.x = (rv[0] >> 16) | (rv[1] & 0xffff0000u); x.y = (rv[2] >> 16) | (rv[3] & 0xffff0000u); *(LAS v2u*)(L + VTL + (k0 + 1) * 80 + ps0 * 2) = x;
                if (to == 7) { *(LAS float*)(L + DLo + k0 * 4) = __expf(bl0); *(LAS float*)(L + DLo + k0 * 4 + 4) = __expf(bl1); *(LAS float*)(L + DMo + k0 * 4) = __expf(bm0); *(LAS float*)(L + DMo + k0 * 4 + 4) = __expf(bm1); }
            }
            const v4u gcur = rgate;
            __syncthreads();
            if (c + 1 < SEQ / 32) {
                const bf16* pn = pq + (size_t)(c + 1) * 32 * HG_IN;
#pragma unroll
                for (int i = 0; i < 4; ++i) { rq[i] = *(const unsigned*)(pn + (size_t)i * HG_IN); rf[i] = *(const unsigned*)(pn + (size_t)i * HG_IN + 2048); rv[i] = *(const unsigned*)(pn + (size_t)i * HG_IN + 4096); }
                rgate = *(const v4u*)(pg + (size_t)(c + 1) * 32 * HG_IN);
            }
            {
                bf16x8 Afr[2][4], Bfr[2][4];
#pragma unroll
                for (int tt = 0; tt < 2; ++tt)
#pragma unroll
                    for (int kb = 0; kb < 4; ++kb) { Afr[tt][kb] = *(const LAS bf16x8*)(L + AL + (16 * tt + c16) * 272 + (32 * kb + 8 * g) * 2); Bfr[tt][kb] = *(const LAS bf16x8*)(L + BL + (16 * tt + c16) * 272 + (32 * kb + 8 * g) * 2); }
                f32x4 Oacc[2] = {(f32x4){0.f, 0.f, 0.f, 0.f}, (f32x4){0.f, 0.f, 0.f, 0.f}};
#pragma unroll
                for (int kb = 0; kb < 4; ++kb) {
                    const f32x4 d0 = *(const LAS f32x4*)(L + DMo + (32 * kb + 4 * g) * 4), d1 = *(const LAS f32x4*)(L + DMo + (32 * kb + 16 + 4 * g) * 4);
                    const bf16x8 Sb = pack8v(Sacc[2 * kb] * d0, Sacc[2 * kb + 1] * d1);
                    Oacc[0] = __builtin_amdgcn_mfma_f32_16x16x32_bf16(Afr[0][kb], Sb, Oacc[0], 0, 0, 0);
                    Oacc[1] = __builtin_amdgcn_mfma_f32_16x16x32_bf16(Afr[1][kb], Sb, Oacc[1], 0, 0, 0);
                }
                f32x4 P00 = (f32x4){0.f, 0.f, 0.f, 0.f}, P01 = P00, P11 = P00;
#pragma unroll
                for (int kb = 0; kb < 4; ++kb) {
                    P00 = __builtin_amdgcn_mfma_f32_16x16x32_bf16(Bfr[0][kb], Afr[0][kb], P00, 0, 0, 0);
                    P01 = __builtin_amdgcn_mfma_f32_16x16x32_bf16(Bfr[0][kb], Afr[1][kb], P01, 0, 0, 0);
                    P11 = __builtin_amdgcn_mfma_f32_16x16x32_bf16(Bfr[1][kb], Afr[1][kb], P11, 0, 0, 0);
                }
#pragma unroll
                for (int r = 0; r < 4; ++r) if (4 * g + r > c16) { P00[r] = 0.f; P11[r] = 0.f; }
                const bf16x8 Pf0 = pack8v(P00, (f32x4){0.f, 0.f, 0.f, 0.f}), Pf1 = pack8v(P01, P11);
                const bf16x8 Vf = *(const LAS bf16x8*)(L + VTL + (16 * w + c16) * 80 + 16 * g);
                Oacc[0] = __builtin_amdgcn_mfma_f32_16x16x32_bf16(Pf0, Vf, Oacc[0], 0, 0, 0);
                Oacc[1] = __builtin_amdgcn_mfma_f32_16x16x32_bf16(Pf1, Vf, Oacc[1], 0, 0, 0);
#pragma unroll
                for (int kt = 0; kt < 8; ++kt) {
                    const f32x4 dl = *(const LAS f32x4*)(L + DLo + (16 * kt + 4 * g) * 4);
                    const bf16x8 Kf = *(const LAS bf16x8*)(L + KTL + (16 * kt + c16) * 80 + 16 * g);
                    Sacc[kt] = __builtin_amdgcn_mfma_f32_16x16x32_bf16(Kf, Vf, Sacc[kt] * dl, 0, 0, 0);
                }
#pragma unroll
                for (int tt = 0; tt < 2; ++tt)
#pragma unroll
                    for (int r = 0; r < 4; ++r) *(LAS float*)(L + OSo + ((16 * tt + 4 * g + r) * 132 + 16 * w + c16) * 4) = Oacc[tt][r];
            }
            __syncthreads();
            {
                const f32x4 oa = *(const LAS f32x4*)(L + OSo + (et * 132 + ev8) * 4), ob = *(const LAS f32x4*)(L + OSo + (et * 132 + ev8 + 4) * 4);
                float ss = ((oa[0] * oa[0] + oa[1] * oa[1]) + (oa[2] * oa[2] + oa[3] * oa[3])) + ((ob[0] * ob[0] + ob[1] * ob[1]) + (ob[2] * ob[2] + ob[3] * ob[3]));
                ss = row16_sum(ss);
                const float r = rsqrtf(ss * (1.0f / 128.0f) + EPS);
                v4u o;
                o.x = pk2(oa[0] * r * nw0[0] * bflo(gcur.x), oa[1] * r * nw0[1] * bfhi(gcur.x)); o.y = pk2(oa[2] * r * nw0[2] * bflo(gcur.y), oa[3] * r * nw0[3] * bfhi(gcur.y));
                o.z = pk2(ob[0] * r * nw1[0] * bflo(gcur.z), ob[1] * r * nw1[1] * bfhi(gcur.z)); o.w = pk2(ob[2] * r * nw1[2] * bflo(gcur.w), ob[3] * r * nw1[3] * bfhi(gcur.w));
                *(v4u*)(O + (size_t)(b * SEQ + c * 32 + et) * DM + h * 128 + ev8) = o;
            }
        }
    }
}

__device__ __forceinline__ bf16x8 frag_lo(const v2u lo) { v4u x; x.x = lo.x; x.y = lo.y; x.z = 0u; x.w = 0u; return __builtin_bit_cast(bf16x8, x); }
__device__ __forceinline__ bf16x8 pack4z(const f32x4 a) { v4u x; x.x = cvtpk_s(a[0], a[1]); x.y = cvtpk_s(a[2], a[3]); x.z = 0u; x.w = 0u; return __builtin_bit_cast(bf16x8, x); }
typedef unsigned short us2 __attribute__((ext_vector_type(2)));
namespace gdn {
constexpr int KL = 0, QL = 9216, KTL = 17408, VL = 27648, SSQ = 44544, TL = 46592, ATL = 48640, NL = 50688, RKo = 55808, RQo = 55936, BEo = 56064, GCo = 56320, NWo = 56576, OL = 57344, CWo = 74240, VTo = 82944, EGo = 103424, ELo = 103680, EGLo = 103936;
}
typedef short s16x4 __attribute__((ext_vector_type(4)));
__device__ __forceinline__ v2u pack4(const f32x4 a) { v2u x; x.x = cvtpk_s(a[0], a[1]); x.y = cvtpk_s(a[2], a[3]); return x; }
__device__ __forceinline__ f32x4 mfma16(const v2u a, const v2u b, const f32x4 c) { return __builtin_amdgcn_mfma_f32_16x16x16bf16_1k(__builtin_bit_cast(s16x4, a), __builtin_bit_cast(s16x4, b), c, 0, 0, 0); }
__device__ __forceinline__ v2u tr_read(const LAS unsigned char* p) { return __builtin_bit_cast(v2u, __builtin_amdgcn_ds_read_tr16_b64_v4i16((LAS s16x4*)p)); }
__device__ __forceinline__ void gdn_pair_step(LAS unsigned char* L, f32x4 (&S0)[8], f32x4 (&S1)[8], int j, int w, int c16, int g) {
    using namespace gdn;
    const int tk = 16 * j + 4 * g;
    const f32x4 rk4 = *(const LAS f32x4*)(L + RKo + tk * 4), rq4 = *(const LAS f32x4*)(L + RQo + tk * 4);
    const f32x4 be0 = *(const LAS f32x4*)(L + BEo + tk * 4), be1 = *(const LAS f32x4*)(L + BEo + (32 + tk) * 4);
    const f32x4 eg0 = *(const LAS f32x4*)(L + EGo + tk * 4), eg1 = *(const LAS f32x4*)(L + EGo + (32 + tk) * 4);
    f32x4 el0 = *(const LAS f32x4*)(L + ELo + tk * 4), el1 = *(const LAS f32x4*)(L + ELo + (32 + tk) * 4);
    const float egl0 = *(const LAS float*)(L + EGLo + (16 * j) * 4), egl1 = *(const LAS float*)(L + EGLo + (32 + 16 * j) * 4);
    bf16x8 Kf[4], Qf[4];
#pragma unroll
    for (int kb = 0; kb < 4; ++kb) { Kf[kb] = *(const LAS bf16x8*)(L + KL + (16 * j + c16) * 288 + (32 * kb + 8 * g) * 2); Qf[kb] = *(const LAS bf16x8*)(L + QL + (16 * j + c16) * 288 + (32 * kb + 8 * g) * 2); }
    const int tq = c16 >> 2, tp = c16 & 3;
    const v2u Vf0 = tr_read(L + VL + (tk + tq) * 544 + (16 * w + 4 * tp) * 2), Vf1 = tr_read(L + VL + (tk + tq) * 544 + (128 + 16 * w + 4 * tp) * 2);
    const v2u Tf0 = *(const LAS v2u*)(L + TL + (2 * j) * 512 + c16 * 32 + 8 * g), Tf1 = *(const LAS v2u*)(L + TL + (2 * j + 1) * 512 + c16 * 32 + 8 * g);
    const v2u Af0 = *(const LAS v2u*)(L + ATL + (2 * j) * 512 + c16 * 32 + 8 * g), Af1 = *(const LAS v2u*)(L + ATL + (2 * j + 1) * 512 + c16 * 32 + 8 * g);
    v2u Ktf[8];
#pragma unroll
    for (int kt = 0; kt < 8; ++kt) Ktf[kt] = tr_read(L + KL + (tk + tq) * 288 + ((16 * kt & ~31) + 8 * tp + 4 * (kt & 1)) * 2);
    __builtin_amdgcn_sched_barrier(0);
    el0 *= rk4; el1 *= rk4;
    const f32x4 Z = (f32x4){0.f, 0.f, 0.f, 0.f};
    f32x4 KS0 = Z, QS0 = Z, KS1 = Z, QS1 = Z;
#pragma unroll
    for (int kb = 0; kb < 4; ++kb) { const bf16x8 Sb0 = pack8v(S0[2 * kb], S0[2 * kb + 1]), Sb1 = pack8v(S1[2 * kb], S1[2 * kb + 1]);
        KS0 = __builtin_amdgcn_mfma_f32_16x16x32_bf16(Kf[kb], Sb0, KS0, 0, 0, 0); KS1 = __builtin_amdgcn_mfma_f32_16x16x32_bf16(Kf[kb], Sb1, KS1, 0, 0, 0);
        QS0 = __builtin_amdgcn_mfma_f32_16x16x32_bf16(Qf[kb], Sb0, QS0, 0, 0, 0); QS1 = __builtin_amdgcn_mfma_f32_16x16x32_bf16(Qf[kb], Sb1, QS1, 0, 0, 0); }
    const f32x4 v0 = {bflo(Vf0.x), bfhi(Vf0.x), bflo(Vf0.y), bfhi(Vf0.y)}, v1 = {bflo(Vf1.x), bfhi(Vf1.x), bflo(Vf1.y), bfhi(Vf1.y)};
    f32x4 R0, R1;
#pragma unroll
    for (int r = 0; r < 4; ++r) { R0[r] = be0[r] * (v0[r] - eg0[r] * rk4[r] * KS0[r]); R1[r] = be1[r] * (v1[r] - eg1[r] * rk4[r] * KS1[r]); }
    const f32x4 vn0 = mfma16(Tf0, pack4(R0), Z), vn1 = mfma16(Tf1, pack4(R1), Z);
    const f32x4 Oa0 = mfma16(Af0, pack4(vn0), Z), Oa1 = mfma16(Af1, pack4(vn1), Z);
    f32x4 X0, X1;
    const int ooff = OL + tk * 528 + (16 * w + c16) * 2;
#pragma unroll
    for (int r = 0; r < 4; ++r) {
        *(LAS unsigned short*)(L + ooff + r * 528) = (unsigned short)f2bf(eg0[r] * rq4[r] * QS0[r] + Oa0[r]);
        *(LAS unsigned short*)(L + ooff + r * 528 + 256) = (unsigned short)f2bf(eg1[r] * rq4[r] * QS1[r] + Oa1[r]);
        X0[r] = el0[r] * vn0[r]; X1[r] = el1[r] * vn1[r];
    }
    const v2u Xf0 = pack4(X0), Xf1 = pack4(X1);
#pragma unroll
    for (int kt = 0; kt < 8; ++kt) { S0[kt] = mfma16(Ktf[kt], Xf0, S0[kt] * egl0); S1[kt] = mfma16(Ktf[kt], Xf1, S1[kt] * egl1); }
}
__device__ __forceinline__ void gdn_scan(Frame& F, const bf16* P, const float* BG, bf16* O, const float* convw, const float* normw) {
    using namespace gdn;
    LAS unsigned char* L = F.lds;
    const int t = F.tid, w = F.wave;
    for (int unit = blockIdx.x; unit < NBATCH * 16; unit += F.G) {
        const int b = unit >> 4, kh = unit & 15;
        f32x4 S0[8], S1[8];
#pragma unroll
        for (int i = 0; i < 8; ++i) { S0[i] = (f32x4){0.f, 0.f, 0.f, 0.f}; S1[i] = (f32x4){0.f, 0.f, 0.f, 0.f}; }
        unsigned raw[19];
        {
            const int c0 = (t >> 1) * 2, hf = t & 1, grp = c0 >> 7, chl = c0 & 127;
            const bf16* pc = P + (size_t)(b * SEQ) * GDN_MAIN + (grp == 0 ? kh * 128 + chl : (grp == 1 ? 2048 + kh * 128 + chl : 4096 + kh * 256 + (c0 - 256)));
#pragma unroll
            for (int i = 0; i < 19; ++i) { const int row = 16 * hf - 3 + i; raw[i] = row >= 0 ? *(const unsigned*)(pc + (size_t)row * GDN_MAIN) : 0u; }
        }
        float bgb = 0.f, bgg = 0.f;
        if (t < 64) { const float* bp = BG + (size_t)(b * SEQ + (t & 31)) * 64 + 2 * kh + (t >> 5); bgb = bp[0]; bgg = bp[32]; }
        __syncthreads();
        if (t < 128) *(LAS float*)(L + NWo + t * 4) = normw[t];
        {
            const int c0 = (t >> 1) * 2, grp = c0 >> 7, chl = c0 & 127; const float* cwp = convw + (grp == 0 ? kh * 128 + chl : (grp == 1 ? 2048 + kh * 128 + chl : 4096 + kh * 256 + (c0 - 256)));
            if ((t & 1) == 0) {
#pragma unroll
                for (int k = 0; k < 4; ++k) { const float2 wv = *(const float2*)(cwp + k * 8192); *(LAS float*)(L + CWo + (t >> 1) * 32 + k * 8) = wv.x; *(LAS float*)(L + CWo + (t >> 1) * 32 + k * 8 + 4) = wv.y; }
            }
        }
        for (int sc = 0; sc < SEQ / 32; ++sc) {
            int tl_ = t; asm volatile("" : "+v"(tl_));
            const int lane = tl_ & 63, c16 = lane & 15, g = lane >> 4, et = tl_ >> 4, eseg = tl_ & 15, ehs = eseg >> 3, evb = (eseg & 7) * 16;
            const int c0 = (tl_ >> 1) * 2, hf = tl_ & 1, grp = c0 >> 7, chl = c0 & 127, pkc = (chl & ~31) + kperm(chl & 31);
            const int pcol = grp == 0 ? kh * 128 + chl : (grp == 1 ? 2048 + kh * 128 + chl : 4096 + kh * 256 + (c0 - 256));
            {
                const f32x4 wa = *(const LAS f32x4*)(L + CWo + (tl_ >> 1) * 32), wb = *(const LAS f32x4*)(L + CWo + (tl_ >> 1) * 32 + 16);
                const float2 w0 = {wa[0], wa[1]}, w1 = {wa[2], wa[3]}, w2 = {wb[0], wb[1]}, w3 = {wb[2], wb[3]};
                unsigned pp[16];
#pragma unroll
                for (int j = 0; j < 16; ++j) {
                    const float ya = w0.x * bflo(raw[j]) + w1.x * bflo(raw[j + 1]) + w2.x * bflo(raw[j + 2]) + w3.x * bflo(raw[j + 3]);
                    const float yb = w0.y * bfhi(raw[j]) + w1.y * bfhi(raw[j + 1]) + w2.y * bfhi(raw[j + 2]) + w3.y * bfhi(raw[j + 3]);
                    pp[j] = cvtpk_s(ya * sigm(ya), yb * sigm(yb));
                }
                if (grp <= 1) {
                    const int base = (grp == 0 ? QL : KL) + (16 * hf) * 288 + pkc * 2;
#pragma unroll
                    for (int j = 0; j < 16; ++j) *(LAS unsigned*)(L + base + j * 288) = pp[j];
                } else {
                    const int base = VL + (16 * hf) * 544 + (c0 - 256) * 2;
#pragma unroll
                    for (int j = 0; j < 16; ++j) *(LAS unsigned*)(L + base + j * 544) = pp[j];
                }
            }
            if (tl_ < 64) {
                float s = bgg;
                s += dpp0<0x111>(s); s += dpp0<0x112>(s); s += dpp0<0x114>(s); s += dpp0<0x118>(s);
                float sf = bgg;
                sf += dpp0<0x101>(sf); sf += dpp0<0x102>(sf); sf += dpp0<0x104>(sf); sf += dpp0<0x108>(sf);
                *(LAS float*)(L + GCo + tl_ * 4) = s; *(LAS float*)(L + BEo + tl_ * 4) = bgb;
                *(LAS float*)(L + EGo + tl_ * 4) = __expf(s);
                *(LAS float*)(L + ELo + tl_ * 4) = __expf(sf - bgg);
                *(LAS float*)(L + EGLo + tl_ * 4) = __expf(s + sf - bgg);
            }
            __syncthreads();
            if (sc + 1 < SEQ / 32) {
                const bf16* pc = P + (size_t)(b * SEQ + (sc + 1) * 32 + 16 * hf - 3) * GDN_MAIN + pcol;
#pragma unroll
                for (int i = 0; i < 19; ++i) raw[i] = *(const unsigned*)(pc + (size_t)i * GDN_MAIN);
                if (tl_ < 64) { const float* bp = BG + (size_t)(b * SEQ + (sc + 1) * 32 + (tl_ & 31)) * 64 + 2 * kh + (tl_ >> 5); bgb = bp[0]; bgg = bp[32]; }
            }
            const bf16* zp = P + (size_t)(b * SEQ + sc * 32 + et) * GDN_MAIN + 8192 + (2 * kh + ehs) * 128 + evb;
            const v4u zz0 = *(const v4u*)zp, zz1 = *(const v4u*)(zp + 8);
            if (w < 4) {
                const int j = w >> 1, hh = w & 1;
                f32x4 KKd = (f32x4){0.f, 0.f, 0.f, 0.f}, QKa = KKd, QQd = KKd;
#pragma unroll
                for (int kb = 0; kb < 4; ++kb) { const bf16x8 Kf = *(const LAS bf16x8*)(L + KL + (16 * j + c16) * 288 + (32 * kb + 8 * g) * 2), Qf = *(const LAS bf16x8*)(L + QL + (16 * j + c16) * 288 + (32 * kb + 8 * g) * 2);
                    KKd = __builtin_amdgcn_mfma_f32_16x16x32_bf16(Kf, Kf, KKd, 0, 0, 0); QKa = __builtin_amdgcn_mfma_f32_16x16x32_bf16(Kf, Qf, QKa, 0, 0, 0); QQd = __builtin_amdgcn_mfma_f32_16x16x32_bf16(Qf, Qf, QQd, 0, 0, 0); }
                if (g == (c16 >> 2)) {
                    const int e = c16 & 3;
                    const float dk = e == 0 ? KKd[0] : (e == 1 ? KKd[1] : (e == 2 ? KKd[2] : KKd[3])), dq = e == 0 ? QQd[0] : (e == 1 ? QQd[1] : (e == 2 ? QQd[2] : QQd[3]));
                    *(LAS float*)(L + RKo + (16 * j + c16) * 4) = rsqrtf(dk + EPS); *(LAS float*)(L + RQo + (16 * j + c16) * 4) = rsqrtf(dq + EPS) * 0.08838834764831845f;
                }
                const f32x4 rk4 = *(const LAS f32x4*)(L + RKo + (16 * j + 4 * g) * 4), be4 = *(const LAS f32x4*)(L + BEo + (hh * 32 + 16 * j + 4 * g) * 4), gc4 = *(const LAS f32x4*)(L + GCo + (hh * 32 + 16 * j + 4 * g) * 4);
                const float rkc = *(const LAS float*)(L + RKo + (16 * j + c16) * 4), rqc = *(const LAS float*)(L + RQo + (16 * j + c16) * 4), gcc = *(const LAS float*)(L + GCo + (hh * 32 + 16 * j + c16) * 4), bec = *(const LAS float*)(L + BEo + (hh * 32 + 16 * j + c16) * 4);
                f32x4 a4, nD, nA, iA;
#pragma unroll
                for (int r = 0; r < 4; ++r) {
                    const int x = 4 * g + r;
                    const float kk = rk4[r] * rkc * KKd[r];
                    nD[r] = (c16 < x) ? be4[r] * kk * __expf(gc4[r] - gcc) : 0.f;
                    nA[r] = (x < c16) ? bec * kk * __expf(gcc - gc4[r]) : 0.f;
                    a4[r] = (x <= c16) ? rqc * rk4[r] * QKa[r] * __expf(gcc - gc4[r]) : 0.f;
                    iA[r] = (x == c16) ? 1.f : 0.f;
                }
                { v2u x; x.x = cvtpk_s(a4[0], a4[1]); x.y = cvtpk_s(a4[2], a4[3]); *(LAS v2u*)(L + ATL + w * 512 + c16 * 32 + 8 * g) = x; }
                const f32x4 Z = (f32x4){0.f, 0.f, 0.f, 0.f};
                const bf16x8 fND = pack4z(nD), fNA = pack4z(nA);
                const f32x4 n2D = __builtin_amdgcn_mfma_f32_16x16x32_bf16(fNA, fND, Z, 0, 0, 0), n2A = __builtin_amdgcn_mfma_f32_16x16x32_bf16(fND, fNA, Z, 0, 0, 0);
                const bf16x8 fN2D = pack4z(n2D), fN2A = pack4z(n2A);
                const f32x4 n4D = __builtin_amdgcn_mfma_f32_16x16x32_bf16(fN2A, fN2D, Z, 0, 0, 0), n4A = __builtin_amdgcn_mfma_f32_16x16x32_bf16(fN2D, fN2A, Z, 0, 0, 0);
                const f32x4 n3A = __builtin_amdgcn_mfma_f32_16x16x32_bf16(fN2D, fNA, Z, 0, 0, 0);
                const bf16x8 fN4D = pack4z(n4D), fN4A = pack4z(n4A);
                const f32x4 n8D = __builtin_amdgcn_mfma_f32_16x16x32_bf16(fN4A, fN4D, Z, 0, 0, 0);
                const f32x4 t1A = iA - nA + n2A - n3A;
                const f32x4 t2A = __builtin_amdgcn_mfma_f32_16x16x32_bf16(fN4D, pack4z(t1A), t1A, 0, 0, 0);
                const f32x4 t3A = __builtin_amdgcn_mfma_f32_16x16x32_bf16(pack4z(n8D), pack4z(t2A), t2A, 0, 0, 0);
                { v2u x; x.x = cvtpk_s(t3A[0], t3A[1]); x.y = cvtpk_s(t3A[2], t3A[3]); *(LAS v2u*)(L + TL + w * 512 + c16 * 32 + 8 * g) = x; }
            }
            __syncthreads();
            gdn_pair_step(L, S0, S1, 0, w, c16, g);
            gdn_pair_step(L, S0, S1, 1, w, c16, g);
            __syncthreads();
            {
                f32x4 nwv[4];
#pragma unroll
                for (int i = 0; i < 4; ++i) nwv[i] = *(const LAS f32x4*)(L + NWo + (evb + 4 * i) * 4);
                const v4u o0 = *(const LAS v4u*)(L + OL + et * 528 + (ehs * 128 + evb) * 2), o1 = *(const LAS v4u*)(L + OL + et * 528 + (ehs * 128 + evb) * 2 + 16);
                float ss = 0.f;
                { const unsigned ow[8] = {o0.x, o0.y, o0.z, o0.w, o1.x, o1.y, o1.z, o1.w};
#pragma unroll
                  for (int i = 0; i < 8; ++i) ss += bflo(ow[i]) * bflo(ow[i]) + bfhi(ow[i]) * bfhi(ow[i]); }
                const float r = rsqrtf(oct_sum(ss) * (1.0f / 128.0f) + EPS);
                v4u y0, y1;
                y0.x = pk2(bflo(o0.x) * r * nwv[0][0] * bflo(zz0.x), bfhi(o0.x) * r * nwv[0][1] * bfhi(zz0.x)); y0.y = pk2(bflo(o0.y) * r * nwv[0][2] * bflo(zz0.y), bfhi(o0.y) * r * nwv[0][3] * bfhi(zz0.y));
                y0.z = pk2(bflo(o0.z) * r * nwv[1][0] * bflo(zz0.z), bfhi(o0.z) * r * nwv[1][1] * bfhi(zz0.z)); y0.w = pk2(bflo(o0.w) * r * nwv[1][2] * bflo(zz0.w), bfhi(o0.w) * r * nwv[1][3] * bfhi(zz0.w));
                y1.x = pk2(bflo(o1.x) * r * nwv[2][0] * bflo(zz1.x), bfhi(o1.x) * r * nwv[2][1] * bfhi(zz1.x)); y1.y = pk2(bflo(o1.y) * r * nwv[2][2] * bflo(zz1.y), bfhi(o1.y) * r * nwv[2][3] * bfhi(zz1.y));
                y1.z = pk2(bflo(o1.z) * r * nwv[3][0] * bflo(zz1.z), bfhi(o1.z) * r * nwv[3][1] * bfhi(zz1.z)); y1.w = pk2(bflo(o1.w) * r * nwv[3][2] * bflo(zz1.w), bfhi(o1.w) * r * nwv[3][3] * bfhi(zz1.w));
                bf16* op = O + (size_t)(b * SEQ + sc * 32 + et) * GDN_VAL + (2 * kh + ehs) * 128 + evb;
                *(v4u*)op = y0; *(v4u*)(op + 8) = y1;
            }
        }
    }
}

struct Args { const float* in[17]; float* out; unsigned char* ws; int ph_lo, ph_hi; };
#define CW_BAR 4096
__global__ void __launch_bounds__(NWAVES * 64, 2) trunk_fwd(Args args) {
    extern __shared__ __attribute__((aligned(16))) unsigned char lds[];
    Frame F;
    F.lds = (LAS unsigned char*)lds;
    F.MISC = (volatile LAS unsigned*)(F.lds + MISC_OFF);
    F.tid = threadIdx.x; F.lane = F.tid & 63; F.wave = __builtin_amdgcn_readfirstlane(F.tid >> 6);
    F.G = gridDim.x;
    unsigned char* ws = args.ws; F.ws = ws;
    F.ctl = (gu32*)(ws + WS_CTL);
    F.x = args.in[0]; F.c = args.in[1]; F.ada_w = args.in[2]; F.ada_b = args.in[3]; F.norm_w = args.in[4]; F.hg_w_in = args.in[5]; F.hg_lb = args.in[6]; F.hg_norm_w = args.in[7]; F.hg_w_out = args.in[8];
    F.gdn_w_in = args.in[9]; F.gdn_conv_w = args.in[10]; F.gdn_A_log = args.in[11]; F.gdn_dt_bias = args.in[12]; F.gdn_norm_w = args.in[13]; F.gdn_w_out = args.in[14]; F.ffn_gu = args.in[15]; F.ffn_down = args.in[16];
    F.out = args.out;
    for (int u = F.tid; u < (LDS_BYTES - LDSCTL_OFF) / 4; u += NWAVES * 64) ((LAS unsigned*)(F.lds + LDSCTL_OFF))[u] = 0u;
    __syncthreads();
    XcdBarrier bar; bar.bar = (unsigned*)(F.ctl + CW_BAR); bar.x = 0; bar.st = nullptr;
    if (MK_N_LAUNCHES == 1) bar = xcd_barrier_post((unsigned*)(F.ctl + CW_BAR), F.MISC + 8);
    const int lo = args.ph_lo, hi = args.ph_hi;
#define IN(k) (lo <= (k) && (k) < hi)
#define SEAM(k) do { if (MK_N_LAUNCHES == 1 && (k) + 1 < hi) xcd_barrier(bar); } while (0)
    bf16* const HO = (bf16*)(ws + WS_HO); bf16* const PB = (bf16*)(ws + WS_P); bf16* const YB = (bf16*)(ws + WS_Y); float* const BG = (float*)(ws + WS_BG);

    #ifndef NO_P0
    if (IN(0)) { p0_prologue(F); SEAM(0); }
#endif
    if (IN(1)) { row_pass(F, F.x, nullptr, nullptr, nullptr, nullptr, HO, 0, 0, 0, 0, 1, 0, 0); SEAM(1); }
    for (int s = 0; s < 8; ++s) {
        const int l = s >> 1, ffn = s & 1, gdn = l & 1, j = l >> 1, pb = 2 + 4 * s;
        { int tl = threadIdx.x; asm volatile("" : "+v"(tl)); F.tid = tl; F.lane = tl & 63; F.wave = __builtin_amdgcn_readfirstlane(tl >> 6); }
        if (IN(pb)) {
            if (ffn) {
                pg8::Gemm g{HO, (const bf16*)(ws + W_GU + (size_t)l * W_GU_SZ), MTOK, GU, DM}; pg8::StaticOrder S; S.init(MTOK, GU, F.G, (int)blockIdx.x);
                pg8::EpiSwiGLU E{PB, FFH};
                pg8::gemm_phase<pg8::EpiSwiGLU, pg8::StaticOrder, PG8_ALIGN, PG8_SP2>(F.lds, g, S, E);
            } else if (!gdn) {
                pg8::Gemm g{HO, (const bf16*)(ws + W_HGIN + (size_t)j * W_HGIN_SZ), MTOK, HG_IN, DM}; pg8::StaticOrder S; S.init(MTOK, HG_IN, F.G, (int)blockIdx.x);
                pg8::EpiHgProj E{PB, HG_IN, (const float*)(ws + WS_LB) + j * 2048};
                pg8::gemm_phase<pg8::EpiHgProj, pg8::StaticOrder, PG8_ALIGN, PG8_SP2>(F.lds, g, S, E);
            } else {
                const bf16* wt = (const bf16*)(ws + W_GDNIN + (size_t)j * W_GDNIN_SZ);
                pg8::Gemm g{HO, wt, MTOK, GDN_MAIN, DM}; pg8::StaticOrder S; S.init(MTOK, GDN_MAIN, F.G, (int)blockIdx.x);
                pg8::EpiGdnProj E{PB, GDN_MAIN};
                pg8::gemm_phase<pg8::EpiGdnProj, pg8::StaticOrder, PG8_ALIGN, PG8_SP2>(F.lds, g, S, E);
                gdn_tail(F, HO, wt + (size_t)GDN_MAIN * DM, F.gdn_A_log + j * 32, F.gdn_dt_bias + j * 32, BG);
            }
            SEAM(pb);
        }
        if (IN(pb + 1) && !ffn) {
#ifndef NO_HG
            if (!gdn) hgrn_scan(F, PB, HO, F.hg_norm_w + j * 128);
#endif
#ifndef NO_GDN
            if (gdn) gdn_scan(F, PB, BG, HO, F.gdn_conv_w + (size_t)j * 4 * 8192, F.gdn_norm_w + j * 128);
#endif
            SEAM(pb + 1);
        }
        if (IN(pb + 2)) {
            const bf16* A = ffn ? PB : HO;
            const bf16* Bt = ffn ? (const bf16*)(ws + W_DOWN + (size_t)l * W_DOWN_SZ) : (gdn ? (const bf16*)(ws + W_GDNOUT + (size_t)j * W_GDNOUT_SZ) : (const bf16*)(ws + W_HGOUT + (size_t)j * W_HGOUT_SZ));
            const int K = ffn ? FFH : (gdn ? GDN_VAL : DM);
            pg8::Gemm g{A, Bt, MTOK, DM, K}; pg8::StaticOrder S; S.init(MTOK, DM, F.G, (int)blockIdx.x);
            pg8::EpiPlain E{YB, DM};
            pg8::gemm_phase<pg8::EpiPlain, pg8::StaticOrder, PG8_ALIGN, PG8_SP2>(F.lds, g, S, E);
            SEAM(pb + 2);
        }
        if (IN(pb + 3)) {
            const float* xin32 = (s == 0) ? F.x : (const float*)nullptr; bf16* const XM = (bf16*)F.out; bf16* const XA = (bf16*)(ws + WS_HO + 128 * MiB);
            const bf16* xin16 = (s == 7) ? XA : XM; bf16* xo16 = (s == 6) ? XA : XM;
            if (!ffn) row_pass(F, xin32, xin16, YB, nullptr, xo16, HO, l, 2, 1, l, 4, 3, 2);
            else row_pass(F, xin32, xin16, YB, (s == 7) ? F.out : (float*)nullptr, xo16, (s == 7) ? (bf16*)nullptr : HO, l, 5, 3, (s == 7) ? 0 : l + 1, 1, 0, 0);
            SEAM(pb + 3);
        }
    }
#undef IN
#undef SEAM
}

extern "C" void kernel_launch(void* const* d_in, const int* in_sizes, int n_in, void* d_out, int out_size, void* d_ws, size_t ws_size, hipStream_t stream) {
    static int grid = 0;
    if (grid == 0) {
        if (n_in != 17 || in_sizes[0] != MTOK * DM || out_size != MTOK * DM || ws_size < WS_END) { fprintf(stderr, "kernel_launch: unexpected shapes (n_in %d, in0 %d, out %d, ws %zu < %zu); nothing launched\n", n_in, n_in > 0 ? in_sizes[0] : -1, out_size, ws_size, (size_t)WS_END); grid = -1; return; }
        int dev = 0, cus = 0, per_cu = 0;
        if (hipGetDevice(&dev) != hipSuccess || hipDeviceGetAttribute(&cus, hipDeviceAttributeMultiprocessorCount, dev) != hipSuccess) { fprintf(stderr, "kernel_launch: device query failed\n"); grid = -1; return; }
        if (hipFuncSetAttribute((const void*)trunk_fwd, hipFuncAttributeMaxDynamicSharedMemorySize, LDS_BYTES) != hipSuccess) { fprintf(stderr, "kernel_launch: hipFuncSetAttribute failed\n"); grid = -1; return; }
        if (hipOccupancyMaxActiveBlocksPerMultiprocessor(&per_cu, (const void*)trunk_fwd, NWAVES * 64, LDS_BYTES) != hipSuccess || per_cu < 1) fprintf(stderr, "kernel_launch: note: occupancy query reports %d workgroups per CU\n", per_cu);
        (void)hipGetLastError();
        grid = cus;
    }
    if (grid < 0) return;
    if (hipMemsetAsync((char*)d_ws + WS_CTL, 0, CTL_ZERO_BYTES, stream) != hipSuccess) { fprintf(stderr, "kernel_launch: hipMemsetAsync failed\n"); return; }
    Args a{};
    for (int i = 0; i < 17; ++i) a.in[i] = (const float*)d_in[i];
    a.out = (float*)d_out; a.ws = (unsigned char*)d_ws;
    if (MK_N_LAUNCHES == 1) {
        a.ph_lo = 0; a.ph_hi = N_PHASES;
        hipLaunchKernelGGL(trunk_fwd, dim3(grid), dim3(NWAVES * 64), LDS_BYTES, stream, a);
    } else {
        for (int p = 0; p < N_PHASES; ++p) {
            if (p >= 2 && ((p - 2) & 3) == 1 && (((p - 2) >> 2) & 1)) continue;
            a.ph_lo = p; a.ph_hi = p + 1;
            hipLaunchKernelGGL(trunk_fwd, dim3(grid), dim3(NWAVES * 64), LDS_BYTES, stream, a);
        }
    }
    const hipError_t le = hipPeekAtLastError();
    if (le != hipSuccess) fprintf(stderr, "kernel_launch: launch failed: %s\n", hipGetErrorName(le));
}
```

```cpp
#include <hip/hip_runtime.h>
#include <cstdio>
#include <cstdint>
namespace pg8 {
#define PG8_LAS __attribute__((address_space(3)))
typedef unsigned short bf16_t;
typedef short bf16x8 __attribute__((ext_vector_type(8)));
typedef float f32x4 __attribute__((ext_vector_type(4)));
typedef unsigned u32x4 __attribute__((ext_vector_type(4)));
constexpr int BM = 256, BK = 64, HALF = 128, HTB = HALF * BK * 2  , STAGE_BYTES = 8 * HTB, NXCD = 8, WGM = 8;

__host__ __device__ __forceinline__ int lds_byte(int r, int c) { const int st = (r >> 4) * 2 + (c >> 5), rr = r & 15, cc = c & 31, ob = rr * 64 + cc * 2; return st * 1024 + (ob ^ (((ob >> 9) & 1) << 5)); }
__host__ __device__ __forceinline__ void stage_rc(int b, int& R, int& C) { const int st = b / 1024, sb = b % 1024, swz = sb ^ (((sb >> 9) & 1) << 5); R = (st >> 1) * 16 + swz / 64; C = (st & 1) * 32 + (swz % 64) / 2; }
__host__ __device__ __forceinline__ int perm32(int rho) { const int n = rho >> 4, i = rho & 15; return 8 * (i >> 2) + 4 * n + (i & 3); }

struct Unit { int pm, pn; };
struct Gemm { const bf16_t* A; const bf16_t* Bt; int M, N, K; };

struct StaticOrder {
    int nM, nN, nwg, G, c;
    __host__ __device__ void init(int M, int N, int G_, int c_) { nM = M / BM; nN = N / BM; nwg = nM * nN; G = G_; c = c_; }
    __host__ __device__ bool next(int i, Unit& u) const {
        const long L = (long)i * G + c; if (L >= nwg) return false;
        int wgid = (int)L; { const int q = nwg / NXCD, r = nwg % NXCD, xcd = wgid % NXCD, off = wgid / NXCD; wgid = (xcd < r ? xcd * (q + 1) : r * (q + 1) + (xcd - r) * q) + off; }
        const int nig = WGM * nN, gid = wgid / nig, fm = gid * WGM, gsz = (nM - fm) < WGM ? (nM - fm) : WGM;
        u.pm = fm + ((wgid % nig) % gsz); u.pn = (wgid % nig) / gsz;
#ifndef PG8_CG_ROT
#define PG8_CG_ROT 2
#endif
        if (PG8_CG_ROT > 1 && gsz == WGM) { const int ncg = nN / 4, cg = u.pn >> 2, blk = cg / PG8_CG_ROT, nfull = ncg / PG8_CG_ROT;
            if (blk < nfull) { const int xcd = (int)(L % NXCD); u.pn = ((blk * PG8_CG_ROT + (cg - blk * PG8_CG_ROT + xcd) % PG8_CG_ROT) << 2) | (u.pn & 3); } }
        return true;
    }
    __device__ __forceinline__ void a_ready(const Unit&) const {}
    __device__ __forceinline__ void done(const Unit&) const {}
};
__device__ __forceinline__ unsigned cvt_pk_bf16(float lo, float hi) { unsigned r; asm volatile("v_cvt_pk_bf16_f32 %0, %1, %2" : "=v"(r) : "v"(lo), "v"(hi)); return r; }
__device__ __forceinline__ float sigmoid_f(float x) { return __builtin_amdgcn_rcpf(1.0f + __expf(-x)); }
__device__ __forceinline__ float silu_f(float x) { return x * sigmoid_f(x); }
__device__ __forceinline__ u32x4 pack8(const f32x4 a, const f32x4 b) { u32x4 w; w.x = cvt_pk_bf16(a[0], a[1]); w.y = cvt_pk_bf16(a[2], a[3]); w.z = cvt_pk_bf16(b[0], b[1]); w.w = cvt_pk_bf16(b[2], b[3]); return w; }

struct EpiPlain {
    static constexpr bool PERM = true, AFTER_DRAIN = false;
    bf16_t* O; int ldc;
    __device__ __forceinline__ void operator()(const f32x4 (&acc)[2][2][4][2], const Unit& u, int wr, int wc, int fr, int fq) const {
        const int row0 = u.pm * BM + wr * 64 + fr, col0 = u.pn * BM + wc * 32 + 8 * fq;
#pragma unroll
        for (int ai = 0; ai < 2; ++ai)
#pragma unroll
            for (int m = 0; m < 4; ++m) { bf16_t* rowp = O + (size_t)(row0 + ai * HALF + m * 16) * ldc + col0;
#pragma unroll
                for (int bj = 0; bj < 2; ++bj) *(u32x4*)(rowp + bj * HALF) = pack8(acc[ai][bj][m][0], acc[ai][bj][m][1]); }
    }
};
struct EpiSwiGLU {
    static constexpr bool PERM = true, AFTER_DRAIN = false;
    bf16_t* O; int ldc;
    __device__ __forceinline__ void operator()(const f32x4 (&acc)[2][2][4][2], const Unit& u, int wr, int wc, int fr, int fq) const {
        const int row0 = u.pm * BM + wr * 64 + fr, col0 = u.pn * HALF + wc * 32 + 8 * fq;
#pragma unroll
        for (int ai = 0; ai < 2; ++ai)
#pragma unroll
            for (int m = 0; m < 4; ++m) { bf16_t* rowp = O + (size_t)(row0 + ai * HALF + m * 16) * ldc + col0;
                f32x4 h0, h1;
#pragma unroll
                for (int j = 0; j < 4; ++j) { h0[j] = silu_f(acc[ai][0][m][0][j]) * acc[ai][1][m][0][j]; h1[j] = silu_f(acc[ai][0][m][1][j]) * acc[ai][1][m][1][j]; }
                *(u32x4*)rowp = pack8(h0, h1); }
    }
};
struct EpiHgProj {
    static constexpr bool PERM = true, AFTER_DRAIN = false;
    bf16_t* O; int ldc; const float* lb;
    __device__ __forceinline__ void operator()(const f32x4 (&acc)[2][2][4][2], const Unit& u, int wr, int wc, int fr, int fq) const {
        const int row0 = u.pm * BM + wr * 64 + fr, col0 = u.pn * BM + wc * 32 + 8 * fq, seg = u.pn >> 3;
        f32x4 lbv[2][2];
#pragma unroll
        for (int bj = 0; bj < 2; ++bj)
#pragma unroll
            for (int n = 0; n < 2; ++n) lbv[bj][n] = (seg == 1) ? *(const f32x4*)(lb + (col0 - 2048) + bj * HALF + 4 * n) : (f32x4){0.f, 0.f, 0.f, 0.f};
#pragma unroll
        for (int ai = 0; ai < 2; ++ai)
#pragma unroll
            for (int m = 0; m < 4; ++m) { bf16_t* rowp = O + (size_t)(row0 + ai * HALF + m * 16) * ldc + col0;
#pragma unroll
                for (int bj = 0; bj < 2; ++bj) { f32x4 v[2] = {acc[ai][bj][m][0], acc[ai][bj][m][1]};
                    if (seg == 0) {
#pragma unroll
                        for (int n = 0; n < 2; ++n)
#pragma unroll
                            for (int j = 0; j < 4; ++j) v[n][j] = silu_f(v[n][j]);
                    } else if (seg == 1) {
#pragma unroll
                        for (int n = 0; n < 2; ++n)
#pragma unroll
                            for (int j = 0; j < 4; ++j) { const float l = lbv[bj][n][j]; v[n][j] = __logf(l + (1.0f - l) * sigmoid_f(v[n][j])); }
                    } else if (seg == 3) {
#pragma unroll
                        for (int n = 0; n < 2; ++n)
#pragma unroll
                            for (int j = 0; j < 4; ++j) v[n][j] = sigmoid_f(v[n][j]);
                    }
                    *(u32x4*)(rowp + bj * HALF) = pack8(v[0], v[1]); } }
    }
};
struct EpiGdnProj {
    static constexpr bool PERM = true, AFTER_DRAIN = false;
    bf16_t* O; int ldc;
    __device__ __forceinline__ void operator()(const f32x4 (&acc)[2][2][4][2], const Unit& u, int wr, int wc, int fr, int fq) const {
        const int row0 = u.pm * BM + wr * 64 + fr, col0 = u.pn * BM + wc * 32 + 8 * fq; const bool isz = u.pn >= 32;
#pragma unroll
        for (int ai = 0; ai < 2; ++ai)
#pragma unroll
            for (int m = 0; m < 4; ++m) { bf16_t* rowp = O + (size_t)(row0 + ai * HALF + m * 16) * ldc + col0;
#pragma unroll
                for (int bj = 0; bj < 2; ++bj) { f32x4 v[2] = {acc[ai][bj][m][0], acc[ai][bj][m][1]};
                    if (isz) {
#pragma unroll
                        for (int n = 0; n < 2; ++n)
#pragma unroll
                            for (int j = 0; j < 4; ++j) v[n][j] = silu_f(v[n][j]);
                    }
                    *(u32x4*)(rowp + bj * HALF) = pack8(v[0], v[1]); } }
    }
};

template <class Epi, class Sched, bool ALIGN_EPI = false, bool SP2 = false>
__device__ __forceinline__ void gemm_phase(PG8_LAS unsigned char* lds, const Gemm g, const Sched& S, const Epi& E) {
    int tid_ = threadIdx.x; asm volatile("" : "+v"(tid_));
    const int tid = tid_, wid = __builtin_amdgcn_readfirstlane(tid >> 6), lane = tid & 63, wr = wid >> 2, wc = wid & 3, fr = lane & 15, fq = lane >> 4;
    const int K = g.K, nt = K / BK;
    unsigned voffA[2], voffB[2];
#pragma unroll
    for (int i = 0; i < 2; ++i) { int R, C; stage_rc(tid * 16 + i * 8192, R, C); const int Rb = Epi::PERM ? ((R & ~31) + perm32(R & 31)) : R;
        voffA[i] = (unsigned)(R * K + C) * 2u; voffB[i] = (unsigned)(Rb * K + C) * 2u; }
    const size_t kstep = (size_t)(BK * 2);
    const size_t hstep = (size_t)HALF * K * 2;
    const size_t tstep = 2 * hstep;
    const unsigned ldsw = (unsigned)wid * 1024u;
    const int aoff = lds_byte(wr * 64 + fr, fq * 8), boff = lds_byte(wc * 32 + fr, fq * 8);
#define PG8_SA(b, h) (((b) * 2 + (h)) * HTB)
#define PG8_SB(b, h) ((4 + (b) * 2 + (h)) * HTB)
    const __amdgpu_buffer_rsrc_t rsrc_voffA = __builtin_amdgcn_make_buffer_rsrc((void*)g.A, 0, -1, 0x00020000), rsrc_voffB = __builtin_amdgcn_make_buffer_rsrc((void*)g.Bt, 0, -1, 0x00020000);
    const char* const base_voffA = (const char*)g.A; const char* const base_voffB = (const char*)g.Bt;
#define PG8_STAGE(bufoff, gbase, voff) do { const unsigned _so = (unsigned)((const char*)(gbase) - base_##voff); _Pragma("unroll") for (int _i = 0; _i < 2; ++_i) \
        __builtin_amdgcn_raw_ptr_buffer_load_lds(rsrc_##voff, (PG8_LAS unsigned*)(lds + (bufoff) + ldsw + _i * 8192), 16, (voff)[_i], _so, 0, 0); } while (0)
#define PG8_LDA(dst, b, h) do { _Pragma("unroll") for (int m = 0; m < 4; ++m) _Pragma("unroll") for (int k = 0; k < 2; ++k) dst[m][k] = *(const PG8_LAS bf16x8*)(lds + PG8_SA(b, h) + aoff + m * 2048 + k * 1024); } while (0)
#define PG8_LDB(dst, b, h) do { _Pragma("unroll") for (int n = 0; n < 2; ++n) _Pragma("unroll") for (int k = 0; k < 2; ++k) dst[n][k] = *(const PG8_LAS bf16x8*)(lds + PG8_SB(b, h) + boff + n * 2048 + k * 1024); } while (0)
#define PG8_MMA(ai, bj, At, Bt) do { __builtin_amdgcn_s_setprio(1); _Pragma("unroll") for (int m = 0; m < 4; ++m) _Pragma("unroll") for (int n = 0; n < 2; ++n) _Pragma("unroll") for (int k = 0; k < 2; ++k) \
        acc[ai][bj][m][n] = __builtin_amdgcn_mfma_f32_16x16x32_bf16(Bt[n][k], At[m][k], acc[ai][bj][m][n], 0, 0, 0); __builtin_amdgcn_s_setprio(0); } while (0)
#define PG8_WAIT_V(n) asm volatile("s_waitcnt vmcnt(" #n ")" ::: "memory")
#define PG8_WAIT_L(n) asm volatile("s_waitcnt lgkmcnt(" #n ")" ::: "memory")
#define PG8_BAR __builtin_amdgcn_s_barrier()
#define PG8_SCHED __builtin_amdgcn_sched_barrier(0)
    Unit cur, nxt; int ui = 0;
    if (!S.next(0, cur)) return;
    f32x4 acc[2][2][4][2];
#pragma unroll
    for (int a = 0; a < 2; ++a)
#pragma unroll
        for (int b = 0; b < 2; ++b)
#pragma unroll
            for (int m = 0; m < 4; ++m)
#pragma unroll
                for (int n = 0; n < 2; ++n) acc[a][b][m][n] = (f32x4){0.f, 0.f, 0.f, 0.f};
    bf16x8 At[4][2], B0[2][2], B1[2][2];
    const char* cA = (const char*)g.A + (size_t)cur.pm * tstep; const char* cB = (const char*)g.Bt + (size_t)cur.pn * tstep;
    S.a_ready(cur);
    if constexpr (SP2) {
        PG8_STAGE(PG8_SB(0, 0), cB, voffB); PG8_STAGE(PG8_SB(0, 1), cB + hstep, voffB); PG8_STAGE(PG8_SA(0, 0), cA, voffA); PG8_STAGE(PG8_SA(0, 1), cA + hstep, voffA);
        if (wr == 1) PG8_BAR;
        PG8_WAIT_V(2); PG8_BAR;
        PG8_STAGE(PG8_SB(1, 0), cB + kstep, voffB); PG8_STAGE(PG8_SA(1, 0), cA + kstep, voffA); PG8_STAGE(PG8_SB(1, 1), cB + hstep + kstep, voffB);
        PG8_WAIT_V(6); PG8_BAR;
    } else {
        PG8_STAGE(PG8_SB(0, 0), cB, voffB); PG8_STAGE(PG8_SA(0, 0), cA, voffA); PG8_STAGE(PG8_SB(0, 1), cB + hstep, voffB); PG8_STAGE(PG8_SA(0, 1), cA + hstep, voffA);
        if (wr == 1) PG8_BAR;
        PG8_WAIT_V(4); PG8_BAR;
        PG8_STAGE(PG8_SB(1, 0), cB + kstep, voffB); PG8_STAGE(PG8_SA(1, 0), cA + kstep, voffA); PG8_STAGE(PG8_SB(1, 1), cB + hstep + kstep, voffB);
        PG8_WAIT_V(6); PG8_BAR;
    }
    for (;;) {
        const bool has_next = S.next(ui + 1, nxt);
        const char* nA = has_next ? (const char*)g.A + (size_t)nxt.pm * tstep : cA; const char* nB = has_next ? (const char*)g.Bt + (size_t)nxt.pn * tstep : cB;
        for (int t = 0; t < nt; t += 2) {
            const bool last = (t == nt - 2);
            const char* a1 = cA + (size_t)(t + 1) * kstep;
            const char* a2 = last ? nA : cA + (size_t)(t + 2) * kstep; const char* b2 = last ? nB : cB + (size_t)(t + 2) * kstep;
            const char* a3 = a2 + kstep; const char* b3 = b2 + kstep;
            if (last && has_next) S.a_ready(nxt);
            if constexpr (SP2) {
            PG8_LDB(B0, 0, 0); PG8_LDB(B1, 0, 1); PG8_SCHED; PG8_LDA(At, 0, 0); PG8_STAGE(PG8_SA(1, 1), a1 + hstep, voffA);
            PG8_WAIT_V(8); PG8_WAIT_L(0); PG8_BAR; PG8_MMA(0, 0, At, B0); PG8_MMA(0, 1, At, B1); PG8_BAR; PG8_SCHED;
            PG8_LDA(At, 0, 1); PG8_STAGE(PG8_SB(0, 0), b2, voffB); PG8_STAGE(PG8_SB(0, 1), b2 + hstep, voffB); PG8_STAGE(PG8_SA(0, 0), a2, voffA);
            PG8_WAIT_V(8); PG8_WAIT_L(0); PG8_BAR; PG8_MMA(1, 0, At, B0); PG8_MMA(1, 1, At, B1); PG8_BAR; PG8_SCHED;
            PG8_LDB(B0, 1, 0); PG8_LDB(B1, 1, 1); PG8_SCHED; PG8_LDA(At, 1, 0); PG8_STAGE(PG8_SA(0, 1), a2 + hstep, voffA);
            PG8_WAIT_V(8); PG8_WAIT_L(0); PG8_BAR; PG8_MMA(0, 0, At, B0); PG8_MMA(0, 1, At, B1); PG8_BAR; PG8_SCHED;
            PG8_LDA(At, 1, 1); PG8_STAGE(PG8_SB(1, 0), b3, voffB); PG8_STAGE(PG8_SB(1, 1), b3 + hstep, voffB); PG8_STAGE(PG8_SA(1, 0), a3, voffA);
            PG8_WAIT_V(8); PG8_WAIT_L(0); PG8_BAR; PG8_MMA(1, 0, At, B0); PG8_MMA(1, 1, At, B1); PG8_BAR; PG8_SCHED;
            } else {
            PG8_LDB(B0, 0, 0); PG8_SCHED; PG8_LDA(At, 0, 0); PG8_STAGE(PG8_SA(1, 1), a1 + hstep, voffA);
            PG8_WAIT_L(8); PG8_BAR; PG8_WAIT_L(0); PG8_MMA(0, 0, At, B0); PG8_BAR; PG8_SCHED;
            PG8_LDB(B1, 0, 1); PG8_STAGE(PG8_SB(0, 0), b2, voffB);
            PG8_BAR; PG8_WAIT_L(0); PG8_MMA(0, 1, At, B1); PG8_BAR;
            PG8_LDA(At, 0, 1); PG8_STAGE(PG8_SA(0, 0), a2, voffA);
            PG8_BAR; PG8_WAIT_L(0); PG8_MMA(1, 0, At, B0); PG8_BAR; PG8_SCHED;
            PG8_STAGE(PG8_SB(0, 1), b2 + hstep, voffB);
            PG8_WAIT_V(6); PG8_BAR; PG8_MMA(1, 1, At, B1); PG8_BAR;
            PG8_LDB(B0, 1, 0); PG8_SCHED; PG8_LDA(At, 1, 0); PG8_STAGE(PG8_SA(0, 1), a2 + hstep, voffA);
            PG8_WAIT_L(8); PG8_BAR; PG8_WAIT_L(0); PG8_MMA(0, 0, At, B0); PG8_BAR; PG8_SCHED;
            PG8_LDB(B1, 1, 1); PG8_STAGE(PG8_SB(1, 0), b3, voffB);
            PG8_BAR; PG8_WAIT_L(0); PG8_MMA(0, 1, At, B1); PG8_BAR;
            PG8_LDA(At, 1, 1); PG8_STAGE(PG8_SA(1, 0), a3, voffA);
            PG8_BAR; PG8_WAIT_L(0); PG8_MMA(1, 0, At, B0); PG8_BAR; PG8_SCHED;
            PG8_STAGE(PG8_SB(1, 1), b3 + hstep, voffB);
            PG8_WAIT_V(6); PG8_BAR; PG8_MMA(1, 1, At, B1); PG8_BAR;
            }
        }
        if constexpr (ALIGN_EPI) { if (wr == 0) PG8_BAR; }
        if constexpr (!Epi::AFTER_DRAIN) { E(acc, cur, wr, wc, fr, fq); S.done(cur); }
        if (!has_next) break;
#pragma unroll
        for (int a = 0; a < 2; ++a)
#pragma unroll
            for (int b = 0; b < 2; ++b)
#pragma unroll
                for (int m = 0; m < 4; ++m)
#pragma unroll
                    for (int n = 0; n < 2; ++n) acc[a][b][m][n] = (f32x4){0.f, 0.f, 0.f, 0.f};
        cur = nxt; cA = nA; cB = nB; ++ui;
        if constexpr (ALIGN_EPI) { if (wr == 1) PG8_BAR; }
    }
    PG8_WAIT_V(0);
    if constexpr (!ALIGN_EPI) { if (wr == 0) PG8_BAR; }
    PG8_BAR;
    if constexpr (Epi::AFTER_DRAIN) { E.fused(acc, cur, wr, wc, fr, fq, lds, wid, lane); S.done(cur); }
#undef PG8_SA
#undef PG8_SB
#undef PG8_STAGE
#undef PG8_LDA
#undef PG8_LDB
#undef PG8_MMA
#undef PG8_WAIT_V
#undef PG8_WAIT_L
#undef PG8_BAR
#undef PG8_SCHED
}
}
#ifndef PG8_SP2
#define PG8_SP2 true
#endif
#ifndef PG8_ALIGN
#define PG8_ALIGN true
#endif
#ifndef MK_N_LAUNCHES
#define MK_N_LAUNCHES 1
#endif

constexpr int NWAVES = 8;
constexpr int DM = 2048, NBATCH = 16, SEQ = 2048, MTOK = NBATCH * SEQ, DEPTH = 4;
constexpr int HG_IN = 8192, GDN_IN = 12352, GDN_MAIN = 12288, FFH = 5632, GU = 2 * FFH, NMOD = 6 * DM, GDN_VAL = 4096;
constexpr float EPS = 1e-6f;
constexpr int N_PHASES = 2 + 4 * 8;

constexpr size_t MiB = 1u << 20;
constexpr size_t WS_CTL = 0, CTL_ZERO_BYTES = 1 * MiB;
constexpr size_t WS_MODP = 1 * MiB;
constexpr size_t WS_LB = 13 * MiB;
constexpr size_t WS_BG = 14 * MiB;
constexpr size_t WS_W = 24 * MiB;
constexpr size_t W_HGIN = WS_W, W_HGIN_SZ = (size_t)HG_IN * DM * 2;
constexpr size_t W_HGOUT = W_HGIN + 2 * W_HGIN_SZ, W_HGOUT_SZ = (size_t)DM * DM * 2;
constexpr size_t W_GDNIN = W_HGOUT + 2 * W_HGOUT_SZ, W_GDNIN_SZ = (size_t)GDN_IN * DM * 2;
constexpr size_t W_GDNOUT = W_GDNIN + 2 * W_GDNIN_SZ, W_GDNOUT_SZ = (size_t)DM * GDN_VAL * 2;
constexpr size_t W_GU = W_GDNOUT + 2 * W_GDNOUT_SZ, W_GU_SZ = (size_t)GU * DM * 2;
constexpr size_t W_DOWN = W_GU + 4 * W_GU_SZ, W_DOWN_SZ = (size_t)DM * FFH * 2;
constexpr size_t W_END = W_DOWN + 4 * W_DOWN_SZ;
constexpr size_t WS_HO = 500 * MiB;
constexpr size_t WS_P = 756 * MiB;
constexpr size_t WS_Y = WS_P + 512 * MiB;
constexpr size_t WS_END = WS_P + 768 * MiB;
static_assert(W_END <= WS_HO, "weights overflow");
static_assert((size_t)MTOK * FFH * 2 <= 512 * MiB, "hidden must not reach y");

constexpr int RING_BYTES = 131072;
constexpr int LDSCTL_OFF = RING_BYTES, MISC_OFF = LDSCTL_OFF + 320;
constexpr int LDS_BYTES = 147456;

#define GAS __attribute__((address_space(1)))
#define LAS __attribute__((address_space(3)))
typedef unsigned short bf16;
typedef unsigned v4u __attribute__((ext_vector_type(4)));
typedef unsigned v2u __attribute__((ext_vector_type(2)));
typedef float f32x4 __attribute__((ext_vector_type(4)));
typedef short bf16x8 __attribute__((ext_vector_type(8)));
typedef GAS unsigned gu32;
#define RLX_AGENT __ATOMIC_RELAXED, __HIP_MEMORY_SCOPE_AGENT
#define LDS_WAIT() asm volatile("s_waitcnt lgkmcnt(0)" ::: "memory")
#define VM_WAIT() asm volatile("s_waitcnt vmcnt(0)" ::: "memory")
typedef float f32x2_t __attribute__((ext_vector_type(2))); typedef __bf16 bf16x2_t __attribute__((ext_vector_type(2)));
__device__ __forceinline__ unsigned cvtpk_s(float lo, float hi) { f32x2_t v = {lo, hi}; bf16x2_t b = __builtin_convertvector(v, bf16x2_t); return __builtin_bit_cast(unsigned, b); }
__device__ __forceinline__ unsigned pk2(float lo, float hi) { return cvtpk_s(lo, hi); }
__device__ __forceinline__ unsigned f2bf(float f) { return cvtpk_s(f, 0.f) & 0xffffu; }
__device__ __forceinline__ float bflo(unsigned w) { return __builtin_bit_cast(float, w << 16); }
__device__ __forceinline__ float bfhi(unsigned w) { return __builtin_bit_cast(float, w & 0xffff0000u); }
__device__ __forceinline__ float bf1(unsigned short h) { return __builtin_bit_cast(float, ((unsigned)h) << 16); }
template <int CTRL> __device__ __forceinline__ float dpp0(float x) {
    return __builtin_bit_cast(float, __builtin_amdgcn_update_dpp(0, __builtin_bit_cast(int, x), CTRL, 0xf, 0xf, true)); }
__device__ __forceinline__ float row16_sum(float x) {
    x += dpp0<0x128>(x); x += dpp0<0x124>(x); x += dpp0<0x122>(x); x += dpp0<0x121>(x); return x; }
__device__ __forceinline__ float oct_sum(float x) {
    x += dpp0<0x141>(x); x += dpp0<0xB1>(x); x += dpp0<0x4E>(x); return x; }
__device__ __forceinline__ float quad_tot(float x) { x += dpp0<0xB1>(x); x += dpp0<0x4E>(x); return x; }
__device__ __forceinline__ float wave_sum(float v) {
    v = row16_sum(v);
    const int vi = __builtin_bit_cast(int, v);
    return (__builtin_bit_cast(float, __builtin_amdgcn_readlane(vi, 0)) + __builtin_bit_cast(float, __builtin_amdgcn_readlane(vi, 16))) + (__builtin_bit_cast(float, __builtin_amdgcn_readlane(vi, 32)) + __builtin_bit_cast(float, __builtin_amdgcn_readlane(vi, 48)));
}
__device__ __forceinline__ float quad_sum(float x) {
    int xi = __builtin_bit_cast(int, x);
    x += __builtin_bit_cast(float, __builtin_amdgcn_update_dpp(xi, xi, 0xB1, 0xf, 0xf, false));
    xi = __builtin_bit_cast(int, x);
    x += __builtin_bit_cast(float, __builtin_amdgcn_update_dpp(xi, xi, 0x4E, 0xf, 0xf, false));
    return x;
}
__device__ __forceinline__ float sigm(float x) { return __builtin_amdgcn_rcpf(1.0f + __expf(-x)); }

#define XB_TMO      128
#define XB_XCNT(j)  (256  + 64 * (j))
#define XB_XSUB(j)  (1280 + 64 * (j))
#define XB_XGEN(j)  (2304 + 64 * (j))
#define XB_TOP      3328
#define XB_TOPGEN   3392
#define XCD_BAR_WORDS 3456
#define XB_SPIN_CAP (1u << 18)

__device__ __forceinline__ unsigned xb_ld(unsigned* p)              { return __hip_atomic_load(p, __ATOMIC_RELAXED, __HIP_MEMORY_SCOPE_AGENT); }
__device__ __forceinline__ unsigned xb_add(unsigned* p, unsigned v) { return __hip_atomic_fetch_add(p, v, __ATOMIC_RELAXED, __HIP_MEMORY_SCOPE_AGENT); }
__device__ __forceinline__ unsigned xb_xcc_id() { return (unsigned)__builtin_amdgcn_s_getreg((3 << 11) | 20) & 0xFu; }
#define XB_SPIN(cond, bar) do { unsigned _sp = 0; while (cond) { __builtin_amdgcn_s_sleep(1); \
    if ((++_sp & 255u) == 0u) { if (xb_ld(&(bar)[XB_TMO])) break; if (_sp > XB_SPIN_CAP) { atomicAdd(&(bar)[XB_TMO], 1u); break; } } } } while (0)

struct XcdBarrier {
    unsigned* bar; unsigned x;
    volatile LAS unsigned* st;
};

__device__ __forceinline__ XcdBarrier xcd_barrier_post(unsigned* bar, volatile LAS unsigned* st) {
    XcdBarrier b; b.bar = bar; b.x = xb_xcc_id(); b.st = st;
    if (threadIdx.x == 0) (void)xb_add(&bar[XB_XCNT(b.x)], 1u);
    return b;
}
__device__ __forceinline__ void xcd_barrier_complete(unsigned* bar, unsigned x, unsigned& nloc, unsigned& nx) {
    const unsigned G = gridDim.x * gridDim.y * gridDim.z;
    unsigned sum, cnt, mine, sp = 0u;
    for (;;) {
        sum = 0u; cnt = 0u; mine = 0u;
#pragma unroll
        for (unsigned j = 0; j < 16; ++j) { const unsigned c = xb_ld(&bar[XB_XCNT(j)]); sum += c; cnt += (c > 0u) ? 1u : 0u; mine = (j == x) ? c : mine; }
        if (sum == G) break;
        __builtin_amdgcn_s_sleep(1);
        if ((++sp & 255u) == 0u) { if (xb_ld(&bar[XB_TMO])) break; if (sp > XB_SPIN_CAP) { atomicAdd(&bar[XB_TMO], 1u); break; } }
    }
    nloc = mine > 0u ? mine : 1u; nx = cnt > 0u ? cnt : 1u;
}

__device__ __forceinline__ void xcd_barrier(const XcdBarrier& b) {
    asm volatile("s_waitcnt vmcnt(0)" ::: "memory");
    __syncthreads();
    if (threadIdx.x == 0) {
        unsigned* bar = b.bar;
        __builtin_amdgcn_s_waitcnt(0);
        unsigned nloc = b.st[0], nx = b.st[1];
        if (nloc == 0u) { xcd_barrier_complete(bar, b.x, nloc, nx); b.st[0] = nloc; b.st[1] = nx; }
        const unsigned old = xb_add(&bar[XB_XSUB(b.x)], 1u);
        const unsigned gen = old / nloc;
        if (old + 1u == (gen + 1u) * nloc) {
            __builtin_amdgcn_fence(__ATOMIC_RELEASE, "agent");
            asm volatile("s_waitcnt vmcnt(0)" ::: "memory");
            const unsigned og = xb_add(&bar[XB_TOP], 1u);
            const unsigned tg = og / nx;
            if (og + 1u == (tg + 1u) * nx) xb_add(&bar[XB_TOPGEN], 1u);
            else XB_SPIN(xb_ld(&bar[XB_TOPGEN]) == tg, bar);
            __builtin_amdgcn_fence(__ATOMIC_ACQUIRE, "agent");
            xb_add(&bar[XB_XGEN(b.x)], 1u);
            asm volatile("s_waitcnt vmcnt(0)" ::: "memory");
        } else {
            XB_SPIN(xb_ld(&bar[XB_XGEN(b.x)]) == gen, bar);
            __builtin_amdgcn_fence(__ATOMIC_ACQUIRE, "agent");
            asm volatile("s_waitcnt vmcnt(0)" ::: "memory");
        }
    }
    __syncthreads();
}
struct Frame {
    LAS unsigned char* lds;
    volatile LAS unsigned* MISC;
    gu32* ctl;
    int tid, lane, wave, G;
    const float *x, *c, *ada_w, *ada_b, *norm_w, *hg_w_in, *hg_lb, *hg_norm_w, *hg_w_out, *gdn_w_in, *gdn_conv_w, *gdn_A_log, *gdn_dt_bias, *gdn_norm_w, *gdn_w_out, *ffn_gu, *ffn_down;
    float* out; unsigned char* ws;
};

__device__ __forceinline__ void p0_mod_task(Frame& F, int task) {
    const int cb = task % 192, kq = task / 192, l = cb / 48, n0 = (cb % 48) * 256;
    LAS float* CA = (LAS float*)F.lds;
    LAS float* RED = (LAS float*)(F.lds + 32768);
    float* modp = (float*)(F.ws + WS_MODP);
    {
        const int k = F.tid;
#pragma unroll
        for (int b = 0; b < 16; ++b) { const float cv = F.c[b * DM + kq * 512 + k]; CA[k * 16 + b] = cv * sigm(cv); }
    }
    __syncthreads();
    f32x4 acc[16];
#pragma unroll
    for (int b = 0; b < 16; ++b) acc[b] = (f32x4){0.f, 0.f, 0.f, 0.f};
    const float* wp = F.ada_w + ((size_t)l * DM + kq * 512 + F.wave * 64) * NMOD + n0 + 4 * F.lane;
#pragma unroll 4
    for (int kk = 0; kk < 64; ++kk) {
        const f32x4 wv = *(const f32x4*)(wp + (size_t)kk * NMOD);
        const LAS f32x4* cp = (const LAS f32x4*)(CA + (F.wave * 64 + kk) * 16);
        const f32x4 c0 = cp[0], c1 = cp[1], c2 = cp[2], c3 = cp[3];
#pragma unroll
        for (int j = 0; j < 4; ++j) { acc[j] += c0[j] * wv; acc[4 + j] += c1[j] * wv; acc[8 + j] += c2[j] * wv; acc[12 + j] += c3[j] * wv; }
    }
#pragma unroll
    for (int p = 0; p < 4; ++p) {
        __syncthreads();
        LAS f32x4* rp = (LAS f32x4*)(RED + (F.wave * 64 + F.lane) * 16);
        rp[0] = acc[4 * p]; rp[1] = acc[4 * p + 1]; rp[2] = acc[4 * p + 2]; rp[3] = acc[4 * p + 3];
        __syncthreads();
#pragma unroll
        for (int e = 0; e < 2; ++e) {
            const int o = F.tid + 512 * e, bi = o >> 8, nn = o & 255, ln = nn >> 2, ci = nn & 3;
            float s = 0.f;
#pragma unroll
            for (int w = 0; w < 8; ++w) s += RED[(w * 64 + ln) * 16 + bi * 4 + ci];
            modp[(((size_t)kq * 4 + l) * 16 + (4 * p + bi)) * NMOD + n0 + nn] = s;
        }
    }
    __syncthreads();
}
__device__ __forceinline__ void transpose_item(const float* W, int K, int N, bf16* WT, int rowb, int k0, int n0, LAS float* scr, int lane) {
#pragma unroll 8
    for (int i = 0; i < 32; ++i) { const int kk = 2 * i + (lane >> 5); scr[kk * 33 + (lane & 31)] = W[(size_t)(k0 + kk) * N + n0 + (lane & 31)]; }
    LDS_WAIT(); asm volatile("" ::: "memory");
    const int c = lane & 7;
#pragma unroll
    for (int j = 0; j < 4; ++j) { const int n = (lane >> 3) + 8 * j; const LAS float* s = scr + (8 * c) * 33 + n;
        v4u o; o.x = pk2(s[0 * 33], s[1 * 33]); o.y = pk2(s[2 * 33], s[3 * 33]); o.z = pk2(s[4 * 33], s[5 * 33]); o.w = pk2(s[6 * 33], s[7 * 33]);
        *(GAS v4u*)(WT + (size_t)(rowb + n) * K + k0 + 8 * c) = o; }
    LDS_WAIT(); asm volatile("" ::: "memory");
}
constexpr int I_HGIN = (DM / 64) * (HG_IN / 32), I_HGOUT = (DM / 64) * (DM / 32), I_GDNIN = (DM / 64) * (GDN_IN / 32), I_GDNOUT = (GDN_VAL / 64) * (DM / 32), I_GU = (DM / 64) * (GU / 32), I_DOWN = (FFH / 64) * (DM / 32);
constexpr int NITEMS = 2 * I_HGIN + 2 * I_HGOUT + 2 * I_GDNIN + 2 * I_GDNOUT + 4 * I_GU + 4 * I_DOWN;
__device__ __forceinline__ void p0_prologue(Frame& F) {
    for (int task = blockIdx.x; task < 768; task += F.G) p0_mod_task(F, task);
    if (blockIdx.x == 0) {
        float* lb = (float*)(F.ws + WS_LB);
        for (int n = F.tid; n < 2048; n += 512) { const float l0 = F.hg_lb[n], l1 = F.hg_lb[2048 + n]; lb[n] = 0.f; lb[2048 + n] = 1.0f / (1.0f + expf(l0 - l1)); }
    }
    LAS float* scr = (LAS float*)(F.lds + F.wave * 16384);
    const int gw = blockIdx.x * NWAVES + F.wave, NGW = F.G * NWAVES;
    for (int it = gw; it < NITEMS; it += NGW) {
        int r = it, K, N, mode = 0; const float* W; bf16* WT;
        if (r < 2 * I_HGIN) { const int j = r / I_HGIN; r -= j * I_HGIN; W = F.hg_w_in + (size_t)j * DM * HG_IN; WT = (bf16*)(F.ws + W_HGIN + j * W_HGIN_SZ); K = DM; N = HG_IN; }
        else if ((r -= 2 * I_HGIN) < 2 * I_HGOUT) { const int j = r / I_HGOUT; r -= j * I_HGOUT; W = F.hg_w_out + (size_t)j * DM * DM; WT = (bf16*)(F.ws + W_HGOUT + j * W_HGOUT_SZ); K = DM; N = DM; }
        else if ((r -= 2 * I_HGOUT) < 2 * I_GDNIN) { const int j = r / I_GDNIN; r -= j * I_GDNIN; W = F.gdn_w_in + (size_t)j * DM * GDN_IN; WT = (bf16*)(F.ws + W_GDNIN + j * W_GDNIN_SZ); K = DM; N = GDN_IN; }
        else if ((r -= 2 * I_GDNIN) < 2 * I_GDNOUT) { const int j = r / I_GDNOUT; r -= j * I_GDNOUT; W = F.gdn_w_out + (size_t)j * GDN_VAL * DM; WT = (bf16*)(F.ws + W_GDNOUT + j * W_GDNOUT_SZ); K = GDN_VAL; N = DM; }
        else if ((r -= 2 * I_GDNOUT) < 4 * I_GU) { const int j = r / I_GU; r -= j * I_GU; W = F.ffn_gu + (size_t)j * DM * GU; WT = (bf16*)(F.ws + W_GU + j * W_GU_SZ); K = DM; N = GU; mode = 1; }
        else { r -= 4 * I_GU; const int j = r / I_DOWN; r -= j * I_DOWN; W = F.ffn_down + (size_t)j * FFH * DM; WT = (bf16*)(F.ws + W_DOWN + j * W_DOWN_SZ); K = FFH; N = DM; }
        const int nblk = N / 32, kb = r / nblk, nb = r % nblk, k0 = 64 * kb, n0 = 32 * nb;
        int rowb = n0;
        if (mode == 1) rowb = (n0 < FFH) ? 256 * (n0 / 128) + (n0 % 128) : 256 * ((n0 - FFH) / 128) + 128 + ((n0 - FFH) % 128);
        transpose_item(W, K, N, WT, rowb, k0, n0, scr, F.lane);
    }
}

typedef _Float16 h16x4 __attribute__((ext_vector_type(4)));
__device__ __forceinline__ f32x4 modval(const float* modp, const float* ada_b, int l, int b, int off) {
    f32x4 s = *(const f32x4*)(ada_b + (size_t)l * NMOD + off);
#pragma unroll
    for (int kq = 0; kq < 4; ++kq) s += *(const f32x4*)(modp + (((size_t)kq * 4 + l) * 16 + b) * NMOD + off);
    return s;
}
__device__ __forceinline__ void row_pass(Frame& F, const float* xin32, const bf16* xin16, const bf16* y, float* xo32, bf16* xo16, bf16* hout, int lg, int gchunk, int wyi, int lh, int scchunk, int shchunk, int whi) {
    LAS float* GW = (LAS float*)F.lds; LAS float* WSv = GW + 2048; LAS float* SH = GW + 4096;
    const float* modp = (const float*)(F.ws + WS_MODP);
    for (int rb = blockIdx.x; rb < MTOK / 128; rb += F.G) {
        const int b = rb >> 4;
        __syncthreads();
        {
            const int n = 4 * F.tid;
            if (y) { const f32x4 g = modval(modp, F.ada_b, lg, b, gchunk * DM + n); const f32x4 w = *(const f32x4*)(F.norm_w + (size_t)(lg * 4 + wyi) * DM + n); *(LAS f32x4*)(GW + n) = g * w; }
            if (hout) { const f32x4 sc = modval(modp, F.ada_b, lh, b, scchunk * DM + n), sh = modval(modp, F.ada_b, lh, b, shchunk * DM + n); const f32x4 w = *(const f32x4*)(F.norm_w + (size_t)(lh * 4 + whi) * DM + n);
                *(LAS f32x4*)(WSv + n) = w * (sc + 1.0f); *(LAS f32x4*)(SH + n) = sh; }
        }
        __syncthreads();
        for (int i = 0; i < 16; ++i) {
            const size_t row = (size_t)rb * 128 + F.wave + 8 * i;
            f32x4 xv[8];
            if (xin32) {
                const f32x4* xr = (const f32x4*)(xin32 + row * DM) + F.lane;
#pragma unroll
                for (int j = 0; j < 8; ++j) xv[j] = xr[64 * j];
            } else {
                const h16x4* xr = (const h16x4*)(xin16 + row * DM) + F.lane;
#pragma unroll
                for (int j = 0; j < 8; ++j) xv[j] = __builtin_convertvector(xr[64 * j], f32x4);
            }
            if (y) {
                const v2u* yr = (const v2u*)(y + row * DM) + F.lane;
                f32x4 yv[8]; float ss = 0.f;
#pragma unroll
                for (int j = 0; j < 8; ++j) { const v2u w = yr[64 * j]; yv[j] = (f32x4){bflo(w.x), bfhi(w.x), bflo(w.y), bfhi(w.y)}; ss += (yv[j][0] * yv[j][0] + yv[j][1] * yv[j][1]) + (yv[j][2] * yv[j][2] + yv[j][3] * yv[j][3]); }
                const float ry = rsqrtf(wave_sum(ss) * (1.0f / DM) + EPS);
#pragma unroll
                for (int j = 0; j < 8; ++j) { const f32x4 g = *(const LAS f32x4*)(GW + 4 * F.lane + 256 * j); xv[j] += g * (yv[j] * ry); }
                if (xo32) {
                    f32x4* xo = (f32x4*)(xo32 + row * DM) + F.lane;
#pragma unroll
                    for (int j = 0; j < 8; ++j) xo[64 * j] = xv[j];
                } else {
                    h16x4* xo = (h16x4*)(xo16 + row * DM) + F.lane;
#pragma unroll
                    for (int j = 0; j < 8; ++j) xo[64 * j] = __builtin_convertvector(xv[j], h16x4);
                }
            }
            if (hout) {
                float ss = 0.f;
#pragma unroll
                for (int j = 0; j < 8; ++j) ss += (xv[j][0] * xv[j][0] + xv[j][1] * xv[j][1]) + (xv[j][2] * xv[j][2] + xv[j][3] * xv[j][3]);
                const float rx = rsqrtf(wave_sum(ss) * (1.0f / DM) + EPS);
                v2u* ho = (v2u*)(hout + row * DM) + F.lane;
#pragma unroll
                for (int j = 0; j < 8; ++j) { const f32x4 w = *(const LAS f32x4*)(WSv + 4 * F.lane + 256 * j), s = *(const LAS f32x4*)(SH + 4 * F.lane + 256 * j);
                    const f32x4 hv = xv[j] * rx * w + s; v2u o; o.x = pk2(hv[0], hv[1]); o.y = pk2(hv[2], hv[3]); ho[64 * j] = o; }
            }
        }
    }
}

__device__ __forceinline__ void gdn_tail(Frame& F, const bf16* H, const bf16* WT, const float* A_log, const float* dt_bias, float* BG) {
    const int gw = blockIdx.x * NWAVES + F.wave, NGW = F.G * NWAVES, r16 = F.lane & 15, g = F.lane >> 4;
    for (int tile = gw; tile < MTOK / 16; tile += NGW) {
        const int row0 = tile * 16;
        f32x4 acc[4];
#pragma unroll
        for (int nt = 0; nt < 4; ++nt) acc[nt] = (f32x4){0.f, 0.f, 0.f, 0.f};
        const bf16* ap = H + (size_t)(row0 + r16) * DM + 8 * g;
        const bf16* bp = WT + (size_t)r16 * DM + 8 * g;
#pragma unroll 4
        for (int kk = 0; kk < DM / 32; ++kk) {
            const bf16x8 a = *(const bf16x8*)(ap + 32 * kk);
#pragma unroll
            for (int nt = 0; nt < 4; ++nt) { const bf16x8 bb = *(const bf16x8*)(bp + (size_t)nt * 16 * DM + 32 * kk); acc[nt] = __builtin_amdgcn_mfma_f32_16x16x32_bf16(a, bb, acc[nt], 0, 0, 0); }
        }
#pragma unroll
        for (int nt = 0; nt < 4; ++nt)
#pragma unroll
            for (int r = 0; r < 4; ++r) {
                const int row = row0 + 4 * g + r, col = nt * 16 + r16; const float v = acc[nt][r]; float o;
                if (nt < 2) o = sigm(v);
                else { const int hd = col - 32; const float xx = v + dt_bias[hd]; const float sp = xx > 20.f ? xx : log1pf(expf(xx)); o = -expf(A_log[hd]) * sp; }
                BG[(size_t)row * 64 + col] = o;
            }
    }
}

__device__ __forceinline__ int kperm(int kk) { return 8 * ((kk & 15) >> 2) + 4 * (kk >> 4) + (kk & 3); }
__device__ __forceinline__ bf16x8 pack8v(const f32x4 a, const f32x4 b) { v4u w; w.x = cvtpk_s(a[0], a[1]); w.y = cvtpk_s(a[2], a[3]); w.z = cvtpk_s(b[0], b[1]); w.w = cvtpk_s(b[2], b[3]); return __builtin_bit_cast(bf16x8, w); }
__device__ __forceinline__ void hgrn_scan(Frame& F, const bf16* P, bf16* O, const float* normw) {
    LAS unsigned char* L = F.lds;
    constexpr int AL = 0, BL = 8704, KTL = 17408, VTL = 27648, DLo = 37888, DMo = 38400, OSo = 38912;
    const int t = F.tid, w = F.wave, c16 = F.lane & 15, g = F.lane >> 4;
    const int kp = t >> 3, to = t & 7, k0 = 2 * kp;
    const int et = t >> 4, ev8 = (t & 15) * 8;
    const int pk0 = (k0 & ~31) + kperm(k0 & 31);
    const int ps0 = 8 * (to & 3) + 4 * (to >> 2);
    for (int unit = blockIdx.x; unit < NBATCH * 16; unit += F.G) {
        const int b = unit >> 4, h = unit & 15;
        f32x4 Sacc[8];
#pragma unroll
        for (int i = 0; i < 8; ++i) Sacc[i] = (f32x4){0.f, 0.f, 0.f, 0.f};
        const bf16* pq = P + (size_t)(b * SEQ + 4 * to) * HG_IN + h * 128 + k0;
        const bf16* pg = P + (size_t)(b * SEQ + et) * HG_IN + 6144 + h * 128 + ev8;
        unsigned rq[4], rf[4], rv[4];
#pragma unroll
        for (int i = 0; i < 4; ++i) { rq[i] = *(const unsigned*)(pq + (size_t)i * HG_IN); rf[i] = *(const unsigned*)(pq + (size_t)i * HG_IN + 2048); rv[i] = *(const unsigned*)(pq + (size_t)i * HG_IN + 4096); }
        v4u rgate = *(const v4u*)pg;
        const f32x4 nw0 = *(const f32x4*)(normw + ev8), nw1 = *(const f32x4*)(normw + ev8 + 4);
        __syncthreads();
        for (int c = 0; c < SEQ / 32; ++c) {
            {
                float b0[4], b1[4], run0 = 0.f, run1 = 0.f;
#pragma unroll
                for (int i = 0; i < 4; ++i) { run0 += bflo(rf[i]); b0[i] = run0; run1 += bfhi(rf[i]); b1[i] = run1; }
                float s0 = run0, s1 = run1;
                { const float u0 = dpp0<0x111>(s0), u1 = dpp0<0x111>(s1); if (to >= 1) { s0 += u0; s1 += u1; } }
                { const float u0 = dpp0<0x112>(s0), u1 = dpp0<0x112>(s1); if (to >= 2) { s0 += u0; s1 += u1; } }
                { const float u0 = dpp0<0x114>(s0), u1 = dpp0<0x114>(s1); if (to >= 4) { s0 += u0; s1 += u1; } }
                const float off0 = s0 - run0, off1 = s1 - run1;
                const float bl0 = oct_sum(run0), bl1 = oct_sum(run1);
                const float q0 = quad_tot(run0), q1 = quad_tot(run1), q0s = dpp0<0x114>(q0), q1s = dpp0<0x114>(q1);
                const float bm0 = to < 4 ? q0 : q0s, bm1 = to < 4 ? q1 : q1s;
                float kt0[4], kt1[4];
#pragma unroll
                for (int i = 0; i < 4; ++i) {
                    const float bb0 = off0 + b0[i], bb1 = off1 + b1[i];
                    const float kk0 = 1.0f - __expf(bflo(rf[i])), kk1 = 1.0f - __expf(bfhi(rf[i]));
                    const float a0 = bflo(rq[i]) * __expf(bb0 - bm0), a1 = bfhi(rq[i]) * __expf(bb1 - bm1);
                    const float m0 = kk0 * __expf(bm0 - bb0), m1 = kk1 * __expf(bm1 - bb1);
                    kt0[i] = kk0 * __expf(bl0 - bb0); kt1[i] = kk1 * __expf(bl1 - bb1);
                    *(LAS unsigned*)(L + AL + (4 * to + i) * 272 + pk0 * 2) = pk2(a0, a1);
                    *(LAS unsigned*)(L + BL + (4 * to + i) * 272 + pk0 * 2) = pk2(m0, m1);
                }
                v2u x; x.x = pk2(kt0[0], kt0[1]); x.y = pk2(kt0[2], kt0[3]); *(LAS v2u*)(L + KTL + k0 * 80 + ps0 * 2) = x;
                x.x = pk2(kt1[0], kt1[1]); x.y = pk2(kt1[2], kt1[3]); *(LAS v2u*)(L + KTL + (k0 + 1) * 80 + ps0 * 2) = x;
                x.x = (rv[0] & 0xffffu) | (rv[1] << 16); x.y = (rv[2] & 0xffffu) | (rv[3] << 16); *(LAS v2u*)(L + VTL + k0 * 80 + ps0 * 2) = x;
                x.x = (rv[0] >> 16) | (rv[1] & 0xffff0000u); x.y = (rv[2] >> 16) | (rv[3] & 0xffff0000u); *(LAS v2u*)(L + VTL + (k0 + 1) * 80 + ps0 * 2) = x;
                if (to == 7) { *(LAS float*)(L + DLo + k0 * 4) = __expf(bl0); *(LAS float*)(L + DLo + k0 * 4 + 4) = __expf(bl1); *(LAS float*)(L + DMo + k0 * 4) = __expf(bm0); *(LAS float*)(L + DMo + k0 * 4 + 4) = __expf(bm1); }
            }
            const v4u gcur = rgate;
            __syncthreads();
            if (c + 1 < SEQ / 32) {
                const bf16* pn = pq + (size_t)(c + 1) * 32 * HG_IN;
#pragma unroll
                for (int i = 0; i < 4; ++i) { rq[i] = *(const unsigned*)(pn + (size_t)i * HG_IN); rf[i] = *(const unsigned*)(pn + (size_t)i * HG_IN + 2048); rv[i] = *(const unsigned*)(pn + (size_t)i * HG_IN + 4096); }
                rgate = *(const v4u*)(pg + (size_t)(c + 1) * 32 * HG_IN);
            }
            {
                bf16x8 Afr[2][4], Bfr[2][4];
#pragma unroll
                for (int tt = 0; tt < 2; ++tt)
#pragma unroll
                    for (int kb = 0; kb < 4; ++kb) { Afr[tt][kb] = *(const LAS bf16x8*)(L + AL + (16 * tt + c16) * 272 + (32 * kb + 8 * g) * 2); Bfr[tt][kb] = *(const LAS bf16x8*)(L + BL + (16 * tt + c16) * 272 + (32 * kb + 8 * g) * 2); }
                f32x4 Oacc[2] = {(f32x4){0.f, 0.f, 0.f, 0.f}, (f32x4){0.f, 0.f, 0.f, 0.f}};
#pragma unroll
                for (int kb = 0; kb < 4; ++kb) {
                    const f32x4 d0 = *(const LAS f32x4*)(L + DMo + (32 * kb + 4 * g) * 4), d1 = *(const LAS f32x4*)(L + DMo + (32 * kb + 16 + 4 * g) * 4);
                    const bf16x8 Sb = pack8v(Sacc[2 * kb] * d0, Sacc[2 * kb + 1] * d1);
                    Oacc[0] = __builtin_amdgcn_mfma_f32_16x16x32_bf16(Afr[0][kb], Sb, Oacc[0], 0, 0, 0);
                    Oacc[1] = __builtin_amdgcn_mfma_f32_16x16x32_bf16(Afr[1][kb], Sb, Oacc[1], 0, 0, 0);
                }
                f32x4 P00 = (f32x4){0.f, 0.f, 0.f, 0.f}, P01 = P00, P11 = P00;
#pragma unroll
                for (int kb = 0; kb < 4; ++kb) {
                    P00 = __builtin_amdgcn_mfma_f32_16x16x32_bf16(Bfr[0][kb], Afr[0][kb], P00, 0, 0, 0);
                    P01 = __builtin_amdgcn_mfma_f32_16x16x32_bf16(Bfr[0][kb], Afr[1][kb], P01, 0, 0, 0);
                    P11 = __builtin_amdgcn_mfma_f32_16x16x32_bf16(Bfr[1][kb], Afr[1][kb], P11, 0, 0, 0);
                }
#pragma unroll
                for (int r = 0; r < 4; ++r) if (4 * g + r > c16) { P00[r] = 0.f; P11[r] = 0.f; }
                const bf16x8 Pf0 = pack8v(P00, (f32x4){0.f, 0.f, 0.f, 0.f}), Pf1 = pack8v(P01, P11);
                const bf16x8 Vf = *(const LAS bf16x8*)(L + VTL + (16 * w + c16) * 80 + 16 * g);
                Oacc[0] = __builtin_amdgcn_mfma_f32_16x16x32_bf16(Pf0, Vf, Oacc[0], 0, 0, 0);
                Oacc[1] = __builtin_amdgcn_mfma_f32_16x16x32_bf16(Pf1, Vf, Oacc[1], 0, 0, 0);
#pragma unroll
                for (int kt = 0; kt < 8; ++kt) {
                    const f32x4 dl = *(const LAS f32x4*)(L + DLo + (16 * kt + 4 * g) * 4);
                    const bf16x8 Kf = *(const LAS bf16x8*)(L + KTL + (16 * kt + c16) * 80 + 16 * g);
                    Sacc[kt] = __builtin_amdgcn_mfma_f32_16x16x32_bf16(Kf, Vf, Sacc[kt] * dl, 0, 0, 0);
                }
#pragma unroll
                for (int tt = 0; tt < 2; ++tt)
#pragma unroll
                    for (int r = 0; r < 4; ++r) *(LAS float*)(L + OSo + ((16 * tt + 4 * g + r) * 132 + 16 * w + c16) * 4) = Oacc[tt][r];
            }
            __syncthreads();
            {
                const f32x4 oa = *(const LAS f32x4*)(L + OSo + (et * 132 + ev8) * 4), ob = *(const LAS f32x4*)(L + OSo + (et * 132 + ev8 + 4) * 4);
                float ss = ((oa[0] * oa[0] + oa[1] * oa[1]) + (oa[2] * oa[2] + oa[3] * oa[3])) + ((ob[0] * ob[0] + ob[1] * ob[1]) + (ob[2] * ob[2] + ob[3] * ob[3]));
                ss = row16_sum(ss);
                const float r = rsqrtf(ss * (1.0f / 128.0f) + EPS);
                v4u o;
                o.x = pk2(oa[0] * r * nw0[0] * bflo(gcur.x), oa[1] * r * nw0[1] * bfhi(gcur.x)); o.y = pk2(oa[2] * r * nw0[2] * bflo(gcur.y), oa[3] * r * nw0[3] * bfhi(gcur.y));
                o.z = pk2(ob[0] * r * nw1[0] * bflo(gcur.z), ob[1] * r * nw1[1] * bfhi(gcur.z)); o.w = pk2(ob[2] * r * nw1[2] * bflo(gcur.w), ob[3] * r * nw1[3] * bfhi(gcur.w));
                *(v4u*)(O + (size_t)(b * SEQ + c * 32 + et) * DM + h * 128 + ev8) = o;
            }
        }
    }
}

__device__ __forceinline__ bf16x8 frag_lo(const v2u lo) { v4u x; x.x = lo.x; x.y = lo.y; x.z = 0u; x.w = 0u; return __builtin_bit_cast(bf16x8, x); }
__device__ __forceinline__ bf16x8 pack4z(const f32x4 a) { v4u x; x.x = cvtpk_s(a[0], a[1]); x.y = cvtpk_s(a[2], a[3]); x.z = 0u; x.w = 0u; return __builtin_bit_cast(bf16x8, x); }
typedef unsigned short us2 __attribute__((ext_vector_type(2)));
namespace gdn {
constexpr int KL = 0, QL = 8704, KTL = 17408, VL = 27648, SSQ = 44544, TL = 46592, ATL = 48640, NL = 50688, RKo = 55808, RQo = 55936, BEo = 56064, GCo = 56320, NWo = 56576, OL = 57344, CWo = 74240, VTo = 82944, EGo = 103424, ELo = 103680, EGLo = 103936;
}
typedef short s16x4 __attribute__((ext_vector_type(4)));
__device__ __forceinline__ v2u pack4(const f32x4 a) { v2u x; x.x = cvtpk_s(a[0], a[1]); x.y = cvtpk_s(a[2], a[3]); return x; }
__device__ __forceinline__ f32x4 mfma16(const v2u a, const v2u b, const f32x4 c) { return __builtin_amdgcn_mfma_f32_16x16x16bf16_1k(__builtin_bit_cast(s16x4, a), __builtin_bit_cast(s16x4, b), c, 0, 0, 0); }
__device__ __forceinline__ void gdn_pair_step(LAS unsigned char* L, f32x4 (&S0)[8], f32x4 (&S1)[8], int j, int w, int c16, int g) {
    using namespace gdn;
    const int tk = 16 * j + 4 * g;
    const f32x4 rk4 = *(const LAS f32x4*)(L + RKo + tk * 4), rq4 = *(const LAS f32x4*)(L + RQo + tk * 4);
    const f32x4 be0 = *(const LAS f32x4*)(L + BEo + tk * 4), be1 = *(const LAS f32x4*)(L + BEo + (32 + tk) * 4);
    const f32x4 eg0 = *(const LAS f32x4*)(L + EGo + tk * 4), eg1 = *(const LAS f32x4*)(L + EGo + (32 + tk) * 4);
    f32x4 el0 = *(const LAS f32x4*)(L + ELo + tk * 4), el1 = *(const LAS f32x4*)(L + ELo + (32 + tk) * 4);
    const float egl0 = *(const LAS float*)(L + EGLo + (16 * j) * 4), egl1 = *(const LAS float*)(L + EGLo + (32 + 16 * j) * 4);
    bf16x8 Kf[4], Qf[4];
#pragma unroll
    for (int kb = 0; kb < 4; ++kb) { Kf[kb] = *(const LAS bf16x8*)(L + KL + (16 * j + c16) * 272 + (32 * kb + 8 * g) * 2); Qf[kb] = *(const LAS bf16x8*)(L + QL + (16 * j + c16) * 272 + (32 * kb + 8 * g) * 2); }
    const v2u Vf0 = *(const LAS v2u*)(L + VTo + (16 * w + c16) * 80 + tk * 2), Vf1 = *(const LAS v2u*)(L + VTo + (128 + 16 * w + c16) * 80 + tk * 2);
    const v2u Tf0 = *(const LAS v2u*)(L + TL + (2 * j) * 512 + c16 * 32 + 8 * g), Tf1 = *(const LAS v2u*)(L + TL + (2 * j + 1) * 512 + c16 * 32 + 8 * g);
    const v2u Af0 = *(const LAS v2u*)(L + ATL + (2 * j) * 512 + c16 * 32 + 8 * g), Af1 = *(const LAS v2u*)(L + ATL + (2 * j + 1) * 512 + c16 * 32 + 8 * g);
    v2u Ktf[8];
#pragma unroll
    for (int kt = 0; kt < 8; ++kt) Ktf[kt] = *(const LAS v2u*)(L + KTL + (16 * kt + c16) * 80 + tk * 2);
    __builtin_amdgcn_sched_barrier(0);
    el0 *= rk4; el1 *= rk4;
    const f32x4 Z = (f32x4){0.f, 0.f, 0.f, 0.f};
    f32x4 KS0 = Z, QS0 = Z, KS1 = Z, QS1 = Z;
#pragma unroll
    for (int kb = 0; kb < 4; ++kb) { const bf16x8 Sb0 = pack8v(S0[2 * kb], S0[2 * kb + 1]), Sb1 = pack8v(S1[2 * kb], S1[2 * kb + 1]);
        KS0 = __builtin_amdgcn_mfma_f32_16x16x32_bf16(Kf[kb], Sb0, KS0, 0, 0, 0); KS1 = __builtin_amdgcn_mfma_f32_16x16x32_bf16(Kf[kb], Sb1, KS1, 0, 0, 0);
        QS0 = __builtin_amdgcn_mfma_f32_16x16x32_bf16(Qf[kb], Sb0, QS0, 0, 0, 0); QS1 = __builtin_amdgcn_mfma_f32_16x16x32_bf16(Qf[kb], Sb1, QS1, 0, 0, 0); }
    const f32x4 v0 = {bflo(Vf0.x), bfhi(Vf0.x), bflo(Vf0.y), bfhi(Vf0.y)}, v1 = {bflo(Vf1.x), bfhi(Vf1.x), bflo(Vf1.y), bfhi(Vf1.y)};
    f32x4 R0, R1;
#pragma unroll
    for (int r = 0; r < 4; ++r) { R0[r] = be0[r] * (v0[r] - eg0[r] * rk4[r] * KS0[r]); R1[r] = be1[r] * (v1[r] - eg1[r] * rk4[r] * KS1[r]); }
    const f32x4 vn0 = mfma16(Tf0, pack4(R0), Z), vn1 = mfma16(Tf1, pack4(R1), Z);
    const f32x4 Oa0 = mfma16(Af0, pack4(vn0), Z), Oa1 = mfma16(Af1, pack4(vn1), Z);
    f32x4 X0, X1;
    const int ooff = OL + tk * 528 + (16 * w + c16) * 2;
#pragma unroll
    for (int r = 0; r < 4; ++r) {
        *(LAS unsigned short*)(L + ooff + r * 528) = (unsigned short)f2bf(eg0[r] * rq4[r] * QS0[r] + Oa0[r]);
        *(LAS unsigned short*)(L + ooff + r * 528 + 256) = (unsigned short)f2bf(eg1[r] * rq4[r] * QS1[r] + Oa1[r]);
        X0[r] = el0[r] * vn0[r]; X1[r] = el1[r] * vn1[r];
    }
    const v2u Xf0 = pack4(X0), Xf1 = pack4(X1);
#pragma unroll
    for (int kt = 0; kt < 8; ++kt) { S0[kt] = mfma16(Ktf[kt], Xf0, S0[kt] * egl0); S1[kt] = mfma16(Ktf[kt], Xf1, S1[kt] * egl1); }
}
__device__ __forceinline__ void gdn_scan(Frame& F, const bf16* P, const float* BG, bf16* O, const float* convw, const float* normw) {
    using namespace gdn;
    LAS unsigned char* L = F.lds;
    const int t = F.tid, w = F.wave;
    for (int unit = blockIdx.x; unit < NBATCH * 16; unit += F.G) {
        const int b = unit >> 4, kh = unit & 15;
        f32x4 S0[8], S1[8];
#pragma unroll
        for (int i = 0; i < 8; ++i) { S0[i] = (f32x4){0.f, 0.f, 0.f, 0.f}; S1[i] = (f32x4){0.f, 0.f, 0.f, 0.f}; }
        unsigned raw[19];
        {
            const int c0 = (t >> 1) * 2, hf = t & 1, grp = c0 >> 7, chl = c0 & 127;
            const bf16* pc = P + (size_t)(b * SEQ) * GDN_MAIN + (grp == 0 ? kh * 128 + chl : (grp == 1 ? 2048 + kh * 128 + chl : 4096 + kh * 256 + (c0 - 256)));
#pragma unroll
            for (int i = 0; i < 19; ++i) { const int row = 16 * hf - 3 + i; raw[i] = row >= 0 ? *(const unsigned*)(pc + (size_t)row * GDN_MAIN) : 0u; }
        }
        float bgb = 0.f, bgg = 0.f;
        if (t < 64) { const float* bp = BG + (size_t)(b * SEQ + (t & 31)) * 64 + 2 * kh + (t >> 5); bgb = bp[0]; bgg = bp[32]; }
        __syncthreads();
        if (t < 128) *(LAS float*)(L + NWo + t * 4) = normw[t];
        {
            const int c0 = (t >> 1) * 2, grp = c0 >> 7, chl = c0 & 127; const float* cwp = convw + (grp == 0 ? kh * 128 + chl : (grp == 1 ? 2048 + kh * 128 + chl : 4096 + kh * 256 + (c0 - 256)));
            if ((t & 1) == 0) {
#pragma unroll
                for (int k = 0; k < 4; ++k) { const float2 wv = *(const float2*)(cwp + k * 8192); *(LAS float*)(L + CWo + (t >> 1) * 32 + k * 8) = wv.x; *(LAS float*)(L + CWo + (t >> 1) * 32 + k * 8 + 4) = wv.y; }
            }
        }
        for (int sc = 0; sc < SEQ / 32; ++sc) {
            int tl_ = t; asm volatile("" : "+v"(tl_));
            const int lane = tl_ & 63, c16 = lane & 15, g = lane >> 4, et = tl_ >> 4, eseg = tl_ & 15, ehs = eseg >> 3, evb = (eseg & 7) * 16;
            const int c0 = (tl_ >> 1) * 2, hf = tl_ & 1, grp = c0 >> 7, chl = c0 & 127, pkc = (chl & ~31) + kperm(chl & 31);
            const int pcol = grp == 0 ? kh * 128 + chl : (grp == 1 ? 2048 + kh * 128 + chl : 4096 + kh * 256 + (c0 - 256));
            {
                const f32x4 wa = *(const LAS f32x4*)(L + CWo + (tl_ >> 1) * 32), wb = *(const LAS f32x4*)(L + CWo + (tl_ >> 1) * 32 + 16);
                const float2 w0 = {wa[0], wa[1]}, w1 = {wa[2], wa[3]}, w2 = {wb[0], wb[1]}, w3 = {wb[2], wb[3]};
                unsigned pp[16];
#pragma unroll
                for (int j = 0; j < 16; ++j) {
                    const float ya = w0.x * bflo(raw[j]) + w1.x * bflo(raw[j + 1]) + w2.x * bflo(raw[j + 2]) + w3.x * bflo(raw[j + 3]);
                    const float yb = w0.y * bfhi(raw[j]) + w1.y * bfhi(raw[j + 1]) + w2.y * bfhi(raw[j + 2]) + w3.y * bfhi(raw[j + 3]);
                    pp[j] = cvtpk_s(ya * sigm(ya), yb * sigm(yb));
                }
                if (grp <= 1) {
                    const int base = (grp == 0 ? QL : KL) + (16 * hf) * 272 + pkc * 2;
#pragma unroll
                    for (int j = 0; j < 16; ++j) *(LAS unsigned*)(L + base + j * 272) = pp[j];
                    if (grp == 1) {
                        v4u x;
                        x.x = (pp[0] & 0xffffu) | (pp[1] << 16); x.y = (pp[2] & 0xffffu) | (pp[3] << 16); x.z = (pp[4] & 0xffffu) | (pp[5] << 16); x.w = (pp[6] & 0xffffu) | (pp[7] << 16); *(LAS v4u*)(L + KTL + chl * 80 + hf * 32) = x;
                        x.x = (pp[8] & 0xffffu) | (pp[9] << 16); x.y = (pp[10] & 0xffffu) | (pp[11] << 16); x.z = (pp[12] & 0xffffu) | (pp[13] << 16); x.w = (pp[14] & 0xffffu) | (pp[15] << 16); *(LAS v4u*)(L + KTL + chl * 80 + hf * 32 + 16) = x;
                        x.x = (pp[0] >> 16) | (pp[1] & 0xffff0000u); x.y = (pp[2] >> 16) | (pp[3] & 0xffff0000u); x.z = (pp[4] >> 16) | (pp[5] & 0xffff0000u); x.w = (pp[6] >> 16) | (pp[7] & 0xffff0000u); *(LAS v4u*)(L + KTL + (chl + 1) * 80 + hf * 32) = x;
                        x.x = (pp[8] >> 16) | (pp[9] & 0xffff0000u); x.y = (pp[10] >> 16) | (pp[11] & 0xffff0000u); x.z = (pp[12] >> 16) | (pp[13] & 0xffff0000u); x.w = (pp[14] >> 16) | (pp[15] & 0xffff0000u); *(LAS v4u*)(L + KTL + (chl + 1) * 80 + hf * 32 + 16) = x;
                    }
                } else {
                    const int base = VTo + (c0 - 256) * 80 + hf * 32;
                    v4u x;
                    x.x = (pp[0] & 0xffffu) | (pp[1] << 16); x.y = (pp[2] & 0xffffu) | (pp[3] << 16); x.z = (pp[4] & 0xffffu) | (pp[5] << 16); x.w = (pp[6] & 0xffffu) | (pp[7] << 16); *(LAS v4u*)(L + base) = x;
                    x.x = (pp[8] & 0xffffu) | (pp[9] << 16); x.y = (pp[10] & 0xffffu) | (pp[11] << 16); x.z = (pp[12] & 0xffffu) | (pp[13] << 16); x.w = (pp[14] & 0xffffu) | (pp[15] << 16); *(LAS v4u*)(L + base + 16) = x;
                    x.x = (pp[0] >> 16) | (pp[1] & 0xffff0000u); x.y = (pp[2] >> 16) | (pp[3] & 0xffff0000u); x.z = (pp[4] >> 16) | (pp[5] & 0xffff0000u); x.w = (pp[6] >> 16) | (pp[7] & 0xffff0000u); *(LAS v4u*)(L + base + 80) = x;
                    x.x = (pp[8] >> 16) | (pp[9] & 0xffff0000u); x.y = (pp[10] >> 16) | (pp[11] & 0xffff0000u); x.z = (pp[12] >> 16) | (pp[13] & 0xffff0000u); x.w = (pp[14] >> 16) | (pp[15] & 0xffff0000u); *(LAS v4u*)(L + base + 96) = x;
                }
            }
            if (tl_ < 64) {
                float s = bgg;
                s += dpp0<0x111>(s); s += dpp0<0x112>(s); s += dpp0<0x114>(s); s += dpp0<0x118>(s);
                float sf = bgg;
                sf += dpp0<0x101>(sf); sf += dpp0<0x102>(sf); sf += dpp0<0x104>(sf); sf += dpp0<0x108>(sf);
                *(LAS float*)(L + GCo + tl_ * 4) = s; *(LAS float*)(L + BEo + tl_ * 4) = bgb;
                *(LAS float*)(L + EGo + tl_ * 4) = __expf(s);
                *(LAS float*)(L + ELo + tl_ * 4) = __expf(sf - bgg);
                *(LAS float*)(L + EGLo + tl_ * 4) = __expf(s + sf - bgg);
            }
            __syncthreads();
            if (sc + 1 < SEQ / 32) {
                const bf16* pc = P + (size_t)(b * SEQ + (sc + 1) * 32 + 16 * hf - 3) * GDN_MAIN + pcol;
#pragma unroll
                for (int i = 0; i < 19; ++i) raw[i] = *(const unsigned*)(pc + (size_t)i * GDN_MAIN);
                if (tl_ < 64) { const float* bp = BG + (size_t)(b * SEQ + (sc + 1) * 32 + (tl_ & 31)) * 64 + 2 * kh + (tl_ >> 5); bgb = bp[0]; bgg = bp[32]; }
            }
            const bf16* zp = P + (size_t)(b * SEQ + sc * 32 + et) * GDN_MAIN + 8192 + (2 * kh + ehs) * 128 + evb;
            const v4u zz0 = *(const v4u*)zp, zz1 = *(const v4u*)(zp + 8);
            if (w < 4) {
                const int j = w >> 1, hh = w & 1;
                f32x4 KKd = (f32x4){0.f, 0.f, 0.f, 0.f}, QKa = KKd, QQd = KKd;
#pragma unroll
                for (int kb = 0; kb < 4; ++kb) { const bf16x8 Kf = *(const LAS bf16x8*)(L + KL + (16 * j + c16) * 272 + (32 * kb + 8 * g) * 2), Qf = *(const LAS bf16x8*)(L + QL + (16 * j + c16) * 272 + (32 * kb + 8 * g) * 2);
                    KKd = __builtin_amdgcn_mfma_f32_16x16x32_bf16(Kf, Kf, KKd, 0, 0, 0); QKa = __builtin_amdgcn_mfma_f32_16x16x32_bf16(Kf, Qf, QKa, 0, 0, 0); QQd = __builtin_amdgcn_mfma_f32_16x16x32_bf16(Qf, Qf, QQd, 0, 0, 0); }
                if (g == (c16 >> 2)) {
                    const int e = c16 & 3;
                    const float dk = e == 0 ? KKd[0] : (e == 1 ? KKd[1] : (e == 2 ? KKd[2] : KKd[3])), dq = e == 0 ? QQd[0] : (e == 1 ? QQd[1] : (e == 2 ? QQd[2] : QQd[3]));
                    *(LAS float*)(L + RKo + (16 * j + c16) * 4) = rsqrtf(dk + EPS); *(LAS float*)(L + RQo + (16 * j + c16) * 4) = rsqrtf(dq + EPS) * 0.08838834764831845f;
                }
                const f32x4 rk4 = *(const LAS f32x4*)(L + RKo + (16 * j + 4 * g) * 4), be4 = *(const LAS f32x4*)(L + BEo + (hh * 32 + 16 * j + 4 * g) * 4), gc4 = *(const LAS f32x4*)(L + GCo + (hh * 32 + 16 * j + 4 * g) * 4);
                const float rkc = *(const LAS float*)(L + RKo + (16 * j + c16) * 4), rqc = *(const LAS float*)(L + RQo + (16 * j + c16) * 4), gcc = *(const LAS float*)(L + GCo + (hh * 32 + 16 * j + c16) * 4), bec = *(const LAS float*)(L + BEo + (hh * 32 + 16 * j + c16) * 4);
                f32x4 a4, nD, nA, iA;
#pragma unroll
                for (int r = 0; r < 4; ++r) {
                    const int x = 4 * g + r;
                    const float kk = rk4[r] * rkc * KKd[r];
                    nD[r] = (c16 < x) ? be4[r] * kk * __expf(gc4[r] - gcc) : 0.f;
                    nA[r] = (x < c16) ? bec * kk * __expf(gcc - gc4[r]) : 0.f;
                    a4[r] = (x <= c16) ? rqc * rk4[r] * QKa[r] * __expf(gcc - gc4[r]) : 0.f;
                    iA[r] = (x == c16) ? 1.f : 0.f;
                }
                { v2u x; x.x = cvtpk_s(a4[0], a4[1]); x.y = cvtpk_s(a4[2], a4[3]); *(LAS v2u*)(L + ATL + w * 512 + c16 * 32 + 8 * g) = x; }
                const f32x4 Z = (f32x4){0.f, 0.f, 0.f, 0.f};
                const bf16x8 fND = pack4z(nD), fNA = pack4z(nA);
                const f32x4 n2D = __builtin_amdgcn_mfma_f32_16x16x32_bf16(fNA, fND, Z, 0, 0, 0), n2A = __builtin_amdgcn_mfma_f32_16x16x32_bf16(fND, fNA, Z, 0, 0, 0);
                const bf16x8 fN2D = pack4z(n2D), fN2A = pack4z(n2A);
                const f32x4 n4D = __builtin_amdgcn_mfma_f32_16x16x32_bf16(fN2A, fN2D, Z, 0, 0, 0), n4A = __builtin_amdgcn_mfma_f32_16x16x32_bf16(fN2D, fN2A, Z, 0, 0, 0);
                const f32x4 n3A = __builtin_amdgcn_mfma_f32_16x16x32_bf16(fN2D, fNA, Z, 0, 0, 0);
                const bf16x8 fN4D = pack4z(n4D), fN4A = pack4z(n4A);
                const f32x4 n8D = __builtin_amdgcn_mfma_f32_16x16x32_bf16(fN4A, fN4D, Z, 0, 0, 0);
                const f32x4 t1A = iA - nA + n2A - n3A;
                const f32x4 t2A = __builtin_amdgcn_mfma_f32_16x16x32_bf16(fN4D, pack4z(t1A), t1A, 0, 0, 0);
                const f32x4 t3A = __builtin_amdgcn_mfma_f32_16x16x32_bf16(pack4z(n8D), pack4z(t2A), t2A, 0, 0, 0);
                { v2u x; x.x = cvtpk_s(t3A[0], t3A[1]); x.y = cvtpk_s(t3A[2], t3A[3]); *(LAS v2u*)(L + TL + w * 512 + c16 * 32 + 8 * g) = x; }
            }
            __syncthreads();
            gdn_pair_step(L, S0, S1, 0, w, c16, g);
            gdn_pair_step(L, S0, S1, 1, w, c16, g);
            __syncthreads();
            {
                f32x4 nwv[4];
#pragma unroll
                for (int i = 0; i < 4; ++i) nwv[i] = *(const LAS f32x4*)(L + NWo + (evb + 4 * i) * 4);
                const v4u o0 = *(const LAS v4u*)(L + OL + et * 528 + (ehs * 128 + evb) * 2), o1 = *(const LAS v4u*)(L + OL + et * 528 + (ehs * 128 + evb) * 2 + 16);
                float ss = 0.f;
                { const unsigned ow[8] = {o0.x, o0.y, o0.z, o0.w, o1.x, o1.y, o1.z, o1.w};
#pragma unroll
                  for (int i = 0; i < 8; ++i) ss += bflo(ow[i]) * bflo(ow[i]) + bfhi(ow[i]) * bfhi(ow[i]); }
                const float r = rsqrtf(oct_sum(ss) * (1.0f / 128.0f) + EPS);
                v4u y0, y1;
                y0.x = pk2(bflo(o0.x) * r * nwv[0][0] * bflo(zz0.x), bfhi(o0.x) * r * nwv[0][1] * bfhi(zz0.x)); y0.y = pk2(bflo(o0.y) * r * nwv[0][2] * bflo(zz0.y), bfhi(o0.y) * r * nwv[0][3] * bfhi(zz0.y));
                y0.z = pk2(bflo(o0.z) * r * nwv[1][0] * bflo(zz0.z), bfhi(o0.z) * r * nwv[1][1] * bfhi(zz0.z)); y0.w = pk2(bflo(o0.w) * r * nwv[1][2] * bflo(zz0.w), bfhi(o0.w) * r * nwv[1][3] * bfhi(zz0.w));
                y1.x = pk2(bflo(o1.x) * r * nwv[2][0] * bflo(zz1.x), bfhi(o1.x) * r * nwv[2][1] * bfhi(zz1.x)); y1.y = pk2(bflo(o1.y) * r * nwv[2][2] * bflo(zz1.y), bfhi(o1.y) * r * nwv[2][3] * bfhi(zz1.y));
                y1.z = pk2(bflo(o1.z) * r * nwv[3][0] * bflo(zz1.z), bfhi(o1.z) * r * nwv[3][1] * bfhi(zz1.z)); y1.w = pk2(bflo(o1.w) * r * nwv[3][2] * bflo(zz1.w), bfhi(o1.w) * r * nwv[3][3] * bfhi(zz1.w));
                bf16* op = O + (size_t)(b * SEQ + sc * 32 + et) * GDN_VAL + (2 * kh + ehs) * 128 + evb;
                *(v4u*)op = y0; *(v4u*)(op + 8) = y1;
            }
        }
    }
}

struct Args { const float* in[17]; float* out; unsigned char* ws; int ph_lo, ph_hi; };
#define CW_BAR 4096
__global__ void __launch_bounds__(NWAVES * 64, 2) trunk_fwd(Args args) {
    extern __shared__ __attribute__((aligned(16))) unsigned char lds[];
    Frame F;
    F.lds = (LAS unsigned char*)lds;
    F.MISC = (volatile LAS unsigned*)(F.lds + MISC_OFF);
    F.tid = threadIdx.x; F.lane = F.tid & 63; F.wave = __builtin_amdgcn_readfirstlane(F.tid >> 6);
    F.G = gridDim.x;
    unsigned char* ws = args.ws; F.ws = ws;
    F.ctl = (gu32*)(ws + WS_CTL);
    F.x = args.in[0]; F.c = args.in[1]; F.ada_w = args.in[2]; F.ada_b = args.in[3]; F.norm_w = args.in[4]; F.hg_w_in = args.in[5]; F.hg_lb = args.in[6]; F.hg_norm_w = args.in[7]; F.hg_w_out = args.in[8];
    F.gdn_w_in = args.in[9]; F.gdn_conv_w = args.in[10]; F.gdn_A_log = args.in[11]; F.gdn_dt_bias = args.in[12]; F.gdn_norm_w = args.in[13]; F.gdn_w_out = args.in[14]; F.ffn_gu = args.in[15]; F.ffn_down = args.in[16];
    F.out = args.out;
    for (int u = F.tid; u < (LDS_BYTES - LDSCTL_OFF) / 4; u += NWAVES * 64) ((LAS unsigned*)(F.lds + LDSCTL_OFF))[u] = 0u;
    __syncthreads();
    XcdBarrier bar; bar.bar = (unsigned*)(F.ctl + CW_BAR); bar.x = 0; bar.st = nullptr;
    if (MK_N_LAUNCHES == 1) bar = xcd_barrier_post((unsigned*)(F.ctl + CW_BAR), F.MISC + 8);
    const int lo = args.ph_lo, hi = args.ph_hi;
#define IN(k) (lo <= (k) && (k) < hi)
#define SEAM(k) do { if (MK_N_LAUNCHES == 1 && (k) + 1 < hi) xcd_barrier(bar); } while (0)
    bf16* const HO = (bf16*)(ws + WS_HO); bf16* const PB = (bf16*)(ws + WS_P); bf16* const YB = (bf16*)(ws + WS_Y); float* const BG = (float*)(ws + WS_BG);

    #ifndef NO_P0
    if (IN(0)) { p0_prologue(F); SEAM(0); }
#endif
    if (IN(1)) { row_pass(F, F.x, nullptr, nullptr, nullptr, nullptr, HO, 0, 0, 0, 0, 1, 0, 0); SEAM(1); }
    for (int s = 0; s < 8; ++s) {
        const int l = s >> 1, ffn = s & 1, gdn = l & 1, j = l >> 1, pb = 2 + 4 * s;
        { int tl = threadIdx.x; asm volatile("" : "+v"(tl)); F.tid = tl; F.lane = tl & 63; F.wave = __builtin_amdgcn_readfirstlane(tl >> 6); }
        if (IN(pb)) {
            if (ffn) {
                pg8::Gemm g{HO, (const bf16*)(ws + W_GU + (size_t)l * W_GU_SZ), MTOK, GU, DM}; pg8::StaticOrder S; S.init(MTOK, GU, F.G, (int)blockIdx.x);
                pg8::EpiSwiGLU E{PB, FFH};
                pg8::gemm_phase<pg8::EpiSwiGLU, pg8::StaticOrder, PG8_ALIGN, PG8_SP2>(F.lds, g, S, E);
            } else if (!gdn) {
                pg8::Gemm g{HO, (const bf16*)(ws + W_HGIN + (size_t)j * W_HGIN_SZ), MTOK, HG_IN, DM}; pg8::StaticOrder S; S.init(MTOK, HG_IN, F.G, (int)blockIdx.x);
                pg8::EpiHgProj E{PB, HG_IN, (const float*)(ws + WS_LB) + j * 2048};
                pg8::gemm_phase<pg8::EpiHgProj, pg8::StaticOrder, PG8_ALIGN, PG8_SP2>(F.lds, g, S, E);
            } else {
                const bf16* wt = (const bf16*)(ws + W_GDNIN + (size_t)j * W_GDNIN_SZ);
                pg8::Gemm g{HO, wt, MTOK, GDN_MAIN, DM}; pg8::StaticOrder S; S.init(MTOK, GDN_MAIN, F.G, (int)blockIdx.x);
                pg8::EpiGdnProj E{PB, GDN_MAIN};
                pg8::gemm_phase<pg8::EpiGdnProj, pg8::StaticOrder, PG8_ALIGN, PG8_SP2>(F.lds, g, S, E);
                gdn_tail(F, HO, wt + (size_t)GDN_MAIN * DM, F.gdn_A_log + j * 32, F.gdn_dt_bias + j * 32, BG);
            }
            SEAM(pb);
        }
        if (IN(pb + 1) && !ffn) {
#ifndef NO_HG
            if (!gdn) hgrn_scan(F, PB, HO, F.hg_norm_w + j * 128);
#endif
#ifndef NO_GDN
            if (gdn) gdn_scan(F, PB, BG, HO, F.gdn_conv_w + (size_t)j * 4 * 8192, F.gdn_norm_w + j * 128);
#endif
            SEAM(pb + 1);
        }
        if (IN(pb + 2)) {
            const bf16* A = ffn ? PB : HO;
            const bf16* Bt = ffn ? (const bf16*)(ws + W_DOWN + (size_t)l * W_DOWN_SZ) : (gdn ? (const bf16*)(ws + W_GDNOUT + (size_t)j * W_GDNOUT_SZ) : (const bf16*)(ws + W_HGOUT + (size_t)j * W_HGOUT_SZ));
            const int K = ffn ? FFH : (gdn ? GDN_VAL : DM);
            pg8::Gemm g{A, Bt, MTOK, DM, K}; pg8::StaticOrder S; S.init(MTOK, DM, F.G, (int)blockIdx.x);
            pg8::EpiPlain E{YB, DM};
            pg8::gemm_phase<pg8::EpiPlain, pg8::StaticOrder, PG8_ALIGN, PG8_SP2>(F.lds, g, S, E);
            SEAM(pb + 2);
        }
        if (IN(pb + 3)) {
            const float* xin32 = (s == 0) ? F.x : (const float*)nullptr; bf16* const XM = (bf16*)F.out; bf16* const XA = (bf16*)(ws + WS_HO + 128 * MiB);
            const bf16* xin16 = (s == 7) ? XA : XM; bf16* xo16 = (s == 6) ? XA : XM;
            if (!ffn) row_pass(F, xin32, xin16, YB, nullptr, xo16, HO, l, 2, 1, l, 4, 3, 2);
            else row_pass(F, xin32, xin16, YB, (s == 7) ? F.out : (float*)nullptr, xo16, (s == 7) ? (bf16*)nullptr : HO, l, 5, 3, (s == 7) ? 0 : l + 1, 1, 0, 0);
            SEAM(pb + 3);
        }
    }
#undef IN
#undef SEAM
}

extern "C" void kernel_launch(void* const* d_in, const int* in_sizes, int n_in, void* d_out, int out_size, void* d_ws, size_t ws_size, hipStream_t stream) {
    static int grid = 0;
    if (grid == 0) {
        if (n_in != 17 || in_sizes[0] != MTOK * DM || out_size != MTOK * DM || ws_size < WS_END) { fprintf(stderr, "kernel_launch: unexpected shapes (n_in %d, in0 %d, out %d, ws %zu < %zu); nothing launched\n", n_in, n_in > 0 ? in_sizes[0] : -1, out_size, ws_size, (size_t)WS_END); grid = -1; return; }
        int dev = 0, cus = 0, per_cu = 0;
        if (hipGetDevice(&dev) != hipSuccess || hipDeviceGetAttribute(&cus, hipDeviceAttributeMultiprocessorCount, dev) != hipSuccess) { fprintf(stderr, "kernel_launch: device query failed\n"); grid = -1; return; }
        if (hipFuncSetAttribute((const void*)trunk_fwd, hipFuncAttributeMaxDynamicSharedMemorySize, LDS_BYTES) != hipSuccess) { fprintf(stderr, "kernel_launch: hipFuncSetAttribute failed\n"); grid = -1; return; }
        if (hipOccupancyMaxActiveBlocksPerMultiprocessor(&per_cu, (const void*)trunk_fwd, NWAVES * 64, LDS_BYTES) != hipSuccess || per_cu < 1) fprintf(stderr, "kernel_launch: note: occupancy query reports %d workgroups per CU\n", per_cu);
        (void)hipGetLastError();
        grid = cus;
    }
    if (grid < 0) return;
    if (hipMemsetAsync((char*)d_ws + WS_CTL, 0, CTL_ZERO_BYTES, stream) != hipSuccess) { fprintf(stderr, "kernel_launch: hipMemsetAsync failed\n"); return; }
    Args a{};
    for (int i = 0; i < 17; ++i) a.in[i] = (const float*)d_in[i];
    a.out = (float*)d_out; a.ws = (unsigned char*)d_ws;
    if (MK_N_LAUNCHES == 1) {
        a.ph_lo = 0; a.ph_hi = N_PHASES;
        hipLaunchKernelGGL(trunk_fwd, dim3(grid), dim3(NWAVES * 64), LDS_BYTES, stream, a);
    } else {
        for (int p = 0; p < N_PHASES; ++p) {
            if (p >= 2 && ((p - 2) & 3) == 1 && (((p - 2) >> 2) & 1)) continue;
            a.ph_lo = p; a.ph_hi = p + 1;
            hipLaunchKernelGGL(trunk_fwd, dim3(grid), dim3(NWAVES * 64), LDS_BYTES, stream, a);
        }
    }
    const hipError_t le = hipPeekAtLastError();
    if (le != hipSuccess) fprintf(stderr, "kernel_launch: launch failed: %s\n", hipGetErrorName(le));
}
```
